# Optimizing an MI355X kernel written in HIP

```python
import jax, jax.numpy as jnp
from jax import lax
import numpy as np

D_MODEL = 1024
BATCH = 1
SEQ = 16384
DEPTH = 1

GRID_W = 64
NA_W = D_MODEL // 2
NA_HEAD_DIM = 64
NA_HEADS = NA_W // NA_HEAD_DIM
NA_KH = 8
NA_KW = 16
ML_W = D_MODEL // 2
ML_HEADS = 4
ML_HEAD_DIM = ML_W // ML_HEADS
MIX_W = NA_W + ML_W
ML_CHUNK = 64
CONV_W = 5
EPS = 1e-6
IN_SPLITS = (NA_W,) * 4 + (ML_W,) * 5 + (ML_HEADS,) * 4
IN_W = 4 * NA_W + 5 * ML_W + 4 * ML_HEADS

kernel_name = 'hybrid_natten2d_bimlstm_block'


def rmsnorm(x, w):
    x32 = x.astype(jnp.float32)
    return x32 * lax.rsqrt(jnp.mean(x32 * x32, axis=-1, keepdims=True) + EPS) * w


def centred_short_conv(u, w, b):
    T = u.shape[1]
    pad = CONV_W // 2
    up = jnp.pad(u, ((0, 0), (pad, pad), (0, 0)))
    out = up[:, 0:T] * w[0]
    for j in range(1, CONV_W):
        out = out + up[:, j:j + T] * w[j]
    return out + b


def neighbourhood_attention(q, k, v, rpb):
    B, T, _ = q.shape
    rows = T // GRID_W
    kh = min(NA_KH, rows)

    def to_grid(t):
        return t.reshape(B, rows, GRID_W, NA_HEADS, NA_HEAD_DIM).transpose(0, 3, 1, 2, 4)

    qg = to_grid(q) * (NA_HEAD_DIM ** -0.5)
    kgrid, vgrid = to_grid(k), to_grid(v)
    r = jnp.arange(rows)
    row_idx = jnp.clip(r - kh // 2, 0, rows - kh)[:, None] + jnp.arange(kh)[None, :]
    kg = kgrid[:, :, row_idx]
    vg = vgrid[:, :, row_idx]
    col = jnp.arange(GRID_W)
    col_start = jnp.clip(col - NA_KW // 2, 0, GRID_W - NA_KW)
    col_mask = (col[None, :] >= col_start[:, None]) & (col[None, :] < col_start[:, None] + NA_KW)
    dy = row_idx - r[:, None] + NA_KH - 1
    dx = jnp.clip(col[None, :] - col[:, None], -(NA_KW - 1), NA_KW - 1) + NA_KW - 1
    bias = rpb[:, dy[:, None, :, None], dx[None, :, None, :]]
    s = jnp.einsum('bhrcd,bhrjkd->bhrcjk', qg, kg).astype(jnp.float32) + bias[None]
    s = jnp.where(col_mask[:, None, :], s, -jnp.inf)
    p = jax.nn.softmax(s.reshape(B, NA_HEADS, rows, GRID_W, kh * GRID_W), axis=-1).reshape(s.shape)
    o = jnp.einsum('bhrcjk,bhrjkd->bhrcd', p, vg)
    return o.transpose(0, 2, 3, 1, 4).reshape(B, T, NA_W)


def mlstm_chunkwise(q, k, v, i_pre, f_pre):
    B, H, T, d = q.shape
    L = ML_CHUNK
    nc = T // L
    q = q.reshape(B, H, nc, L, d)
    k = (k * (d ** -0.5)).reshape(B, H, nc, L, d)
    v = v.reshape(B, H, nc, L, d)
    i_pre = i_pre.reshape(B, H, nc, L)
    b = jnp.cumsum(jax.nn.log_sigmoid(f_pre).reshape(B, H, nc, L), axis=-1)
    b_last = b[..., -1]
    a = b_last[..., None] - b + i_pre

    def step(carry, inp):
        C, n, m = carry
        k_c, v_c, a_c, bl_c = inp
        m_new = jnp.maximum(bl_c + m, jnp.max(a_c, axis=-1))
        decay = jnp.exp(bl_c + m - m_new)
        w = jnp.exp(a_c - m_new[..., None])
        C_new = decay[..., None, None] * C + jnp.einsum('bhs,bhse,bhsd->bhed', w, v_c, k_c)
        n_new = decay[..., None] * n + jnp.einsum('bhs,bhsd->bhd', w, k_c)
        return (C_new, n_new, m_new), (C, n, m)

    init = (jnp.zeros((B, H, d, d), q.dtype), jnp.zeros((B, H, d), q.dtype), jnp.zeros((B, H), q.dtype))
    xs = (jnp.moveaxis(k, 2, 0), jnp.moveaxis(v, 2, 0), jnp.moveaxis(a, 2, 0), jnp.moveaxis(b_last, 2, 0))
    _, (C_prev, n_prev, m_prev) = lax.scan(step, init, xs)
    C_prev = jnp.moveaxis(C_prev, 0, 2)
    n_prev = jnp.moveaxis(n_prev, 0, 2)
    m_prev = jnp.moveaxis(m_prev, 0, 2)

    lower = jnp.tril(jnp.ones((L, L), dtype=bool))
    Dlog = jnp.where(lower, b[..., :, None] - b[..., None, :] + i_pre[..., None, :], -jnp.inf)
    m_inter = b + m_prev[..., None]
    m_t = jnp.maximum(m_inter, jnp.max(Dlog, axis=-1))
    S = jnp.einsum('bhntd,bhnsd->bhnts', q, k) * jnp.exp(Dlog - m_t[..., None])
    inter = jnp.exp(m_inter - m_t)
    num = jnp.einsum('bhnts,bhnse->bhnte', S, v) + inter[..., None] * jnp.einsum('bhned,bhntd->bhnte', C_prev, q)
    den = jnp.sum(S, axis=-1) + inter * jnp.einsum('bhnd,bhntd->bhnt', n_prev, q)
    h = num / jnp.maximum(jnp.abs(den), jnp.exp(-m_t))[..., None]
    return h.reshape(B, H, T, d)


def hybrid_mixer(h, w_in, b_in, conv_w, conv_b, rpb, ml_norm_w, w_out):
    B, T, _ = h.shape
    proj = h @ w_in + b_in
    split_idx = np.cumsum(IN_SPLITS)[:-1].tolist()
    (na_q, na_k, na_v, na_z, ml_q, ml_k, ml_v, ml_o, ml_z,
     i_f, f_f, i_b, f_b) = jnp.split(proj, split_idx, axis=-1)

    na_out = neighbourhood_attention(na_q, na_k, na_v, rpb) * jax.nn.silu(na_z)

    qk = jax.nn.silu(centred_short_conv(jnp.concatenate([ml_q, ml_k], axis=-1), conv_w, conv_b))
    mq, mk = jnp.split(qk, 2, axis=-1)

    def heads(t):
        return t.reshape(B, T, ML_HEADS, ML_HEAD_DIM).transpose(0, 2, 1, 3)

    mq, mk, mv = heads(mq), heads(mk), heads(ml_v)
    i_f, f_f, i_b, f_b = (g.transpose(0, 2, 1) for g in (i_f, f_f, i_b, f_b))
    h_fwd = mlstm_chunkwise(mq, mk, mv, i_f, f_f)
    flip = lambda t: jnp.flip(t, axis=2)
    h_bwd = flip(mlstm_chunkwise(flip(mq), flip(mk), flip(mv), flip(i_b), flip(f_b)))
    hm = (h_fwd + h_bwd).transpose(0, 2, 1, 3) * jax.nn.sigmoid(ml_o).reshape(B, T, ML_HEADS, ML_HEAD_DIM)
    mu = jnp.mean(hm, axis=-1, keepdims=True)
    var = jnp.mean(jnp.square(hm - mu), axis=-1, keepdims=True)
    hm = ((hm - mu) * lax.rsqrt(var + EPS)).reshape(B, T, ML_W) * ml_norm_w
    ml_out = hm * jax.nn.silu(ml_z)

    return jnp.concatenate([na_out, ml_out], axis=-1) @ w_out


def setup_inputs(seed: int = 0) -> dict:
    key = jax.random.key(seed)
    ks = jax.random.split(key, 14)
    D = D_MODEL
    x = jax.random.normal(ks[0], (BATCH, SEQ, D), jnp.float32)
    c = jax.random.normal(ks[1], (BATCH, D), jnp.float32)
    w_ada = jax.random.normal(ks[2], (DEPTH, D, 3 * D), jnp.float32) * (0.5 * D ** -0.5)
    b_ada = jax.random.normal(ks[3], (DEPTH, 3 * D), jnp.float32) * 0.02
    norm_w = 1.0 + 0.1 * jax.random.normal(ks[4], (DEPTH, D), jnp.float32)
    w_in = jax.random.normal(ks[5], (DEPTH, D, IN_W), jnp.float32) * (D ** -0.5)
    n_main = 4 * NA_W + 5 * ML_W
    fgate_base = jnp.linspace(3.0, 6.0, ML_HEADS, dtype=jnp.float32)
    gk = jax.random.split(ks[6], 5)
    b_in = jnp.concatenate([
        0.02 * jax.random.normal(gk[0], (DEPTH, n_main), jnp.float32),
        0.1 * jax.random.normal(gk[1], (DEPTH, ML_HEADS), jnp.float32),
        fgate_base + 0.1 * jax.random.normal(gk[2], (DEPTH, ML_HEADS), jnp.float32),
        0.1 * jax.random.normal(gk[3], (DEPTH, ML_HEADS), jnp.float32),
        fgate_base + 0.1 * jax.random.normal(gk[4], (DEPTH, ML_HEADS), jnp.float32),
    ], axis=-1)
    conv_w = jax.random.normal(ks[7], (DEPTH, CONV_W, 2 * ML_W), jnp.float32) * (CONV_W ** -0.5)
    conv_b = 0.02 * jax.random.normal(ks[8], (DEPTH, 2 * ML_W), jnp.float32)
    rpb = 0.1 * jax.random.normal(ks[9], (DEPTH, NA_HEADS, 2 * NA_KH - 1, 2 * NA_KW - 1), jnp.float32)
    ml_norm_w = 1.0 + 0.1 * jax.random.normal(ks[10], (DEPTH, ML_W), jnp.float32)
    w_out = jax.random.normal(ks[11], (DEPTH, MIX_W, D), jnp.float32) * (MIX_W ** -0.5)
    final_norm_w = 1.0 + 0.1 * jax.random.normal(ks[12], (D,), jnp.float32)
    return {'x': x, 'c': c, 'w_ada': w_ada, 'b_ada': b_ada, 'norm_w': norm_w, 'w_in': w_in,
            'b_in': b_in, 'conv_w': conv_w, 'conv_b': conv_b, 'rpb': rpb, 'ml_norm_w': ml_norm_w,
            'w_out': w_out, 'final_norm_w': final_norm_w}


def reference(x, c, w_ada, b_ada, norm_w, w_in, b_in, conv_w, conv_b, rpb, ml_norm_w, w_out, final_norm_w):
    h_res = x.astype(jnp.float32)
    c_act = jax.nn.silu(c.astype(jnp.float32))
    for l in range(DEPTH):
        mod = c_act @ w_ada[l] + b_ada[l]
        shift, scale, gate = jnp.split(mod, 3, axis=-1)
        h = rmsnorm(h_res, norm_w[l]) * (1.0 + scale[:, None, :]) + shift[:, None, :]
        y = hybrid_mixer(h, w_in[l], b_in[l], conv_w[l], conv_b[l], rpb[l], ml_norm_w[l], w_out[l])
        h_res = h_res + gate[:, None, :] * y
    return rmsnorm(h_res, final_norm_w).astype(x.dtype)
```

```cpp
#define MK_N_LAUNCHES 1
#include <hip/hip_runtime.h>
#include <cstdio>
#include <cstdint>
namespace pg8 {
#define PG8_LAS __attribute__((address_space(3)))
typedef unsigned short bf16_t;
typedef short bf16x8 __attribute__((ext_vector_type(8)));
typedef float f32x4 __attribute__((ext_vector_type(4)));
typedef unsigned u32x4 __attribute__((ext_vector_type(4)));
constexpr int BM = 256, BK = 64, HALF = 128, HTB = HALF * BK * 2  , STAGE_BYTES = 8 * HTB, NXCD = 8, WGM = 8;

__host__ __device__ __forceinline__ int lds_byte(int r, int c) { const int st = (r >> 4) * 2 + (c >> 5), rr = r & 15, cc = c & 31, ob = rr * 64 + cc * 2; return st * 1024 + (ob ^ (((ob >> 9) & 1) << 5)); }
__host__ __device__ __forceinline__ void stage_rc(int b, int& R, int& C) { const int st = b / 1024, sb = b % 1024, swz = sb ^ (((sb >> 9) & 1) << 5); R = (st >> 1) * 16 + swz / 64; C = (st & 1) * 32 + (swz % 64) / 2; }
__host__ __device__ __forceinline__ int perm32(int rho) { const int n = rho >> 4, i = rho & 15; return 8 * (i >> 2) + 4 * n + (i & 3); }

struct Unit { int pm, pn; };
struct Gemm { const bf16_t* A; const bf16_t* Bt; int M, N, K; };

struct StaticOrder {
    int nM, nN, nwg, G, c;
    __host__ __device__ void init(int M, int N, int G_, int c_) { nM = M / BM; nN = N / BM; nwg = nM * nN; G = G_; c = c_; }
    __host__ __device__ bool next(int i, Unit& u) const {
        const long L = (long)i * G + c; if (L >= nwg) return false;
        int wgid = (int)L; { const int q = nwg / NXCD, r = nwg % NXCD, xcd = wgid % NXCD, off = wgid / NXCD; wgid = (xcd < r ? xcd * (q + 1) : r * (q + 1) + (xcd - r) * q) + off; }
        const int nig = WGM * nN, gid = wgid / nig, fm = gid * WGM, gsz = (nM - fm) < WGM ? (nM - fm) : WGM;
        u.pm = fm + ((wgid % nig) % gsz); u.pn = (wgid % nig) / gsz; return true;
    }
    __device__ __forceinline__ void a_ready(const Unit&) const {}
    __device__ __forceinline__ void done(const Unit&) const {}
};

__device__ __forceinline__ unsigned cvt_pk_bf16(float lo, float hi) { unsigned r; asm volatile("v_cvt_pk_bf16_f32 %0, %1, %2" : "=v"(r) : "v"(lo), "v"(hi)); return r; }
typedef float f32x2 __attribute__((ext_vector_type(2)));
__device__ __forceinline__ f32x2 gelu_pk(f32x2 v) {
    const f32x2 av = __builtin_elementwise_abs(v), d = av * 0.2316418882f + 1.0f;
    f32x2 t; t.x = __builtin_amdgcn_rcpf(d.x); t.y = __builtin_amdgcn_rcpf(d.y);
    f32x2 q = t * 0.5307027145f + (-0.7265760135f); q = q * t + 0.7107068705f; q = q * t + (-0.142248368f); q = q * t + 0.127414796f; q = q * t;
    const f32x2 s = (v * v) * (-0.72134752044f);
    f32x2 e; e.x = __builtin_amdgcn_exp2f(s.x); e.y = __builtin_amdgcn_exp2f(s.y);
    const f32x2 m = v * (q * e), r = v - m;
    f32x2 o; o.x = v.x < 0.f ? m.x : r.x; o.y = v.y < 0.f ? m.y : r.y; return o;
}

template <int ACT  > struct EpiBf16 {
    static constexpr bool PERM = true, AFTER_DRAIN = false; static_assert(ACT == 0 || ACT == 1, "EpiBf16: ACT is 0 (none) or 1 (gelu_pk)");
    bf16_t* O; int ldc; const float* bias; int split_cols; size_t split_stride; float scale0;
    __device__ __forceinline__ void operator()(const f32x4 (&acc)[2][2][4][2], const Unit& u, int wr, int wc, int fr, int fq) const {
        const int row0 = u.pm * BM + wr * 64 + fr; int colt = u.pn * BM; bf16_t* base = O;
        float sc = 1.f; if (split_cols) { const int t = colt / split_cols; base += (size_t)t * split_stride; colt -= t * split_cols; if (t == 0) sc = scale0; }
        const int col0 = colt + wc * 32 + 8 * fq, bcol0 = u.pn * BM + wc * 32 + 8 * fq;
        f32x4 bv[2][2];
#pragma unroll
        for (int bj = 0; bj < 2; ++bj)
#pragma unroll
            for (int n = 0; n < 2; ++n) bv[bj][n] = bias ? *(const f32x4*)(bias + bcol0 + bj * HALF + 4 * n) : (f32x4){0.f, 0.f, 0.f, 0.f};
#pragma unroll
        for (int ai = 0; ai < 2; ++ai)
#pragma unroll
            for (int m = 0; m < 4; ++m) { bf16_t* rowp = base + (size_t)(row0 + ai * HALF + m * 16) * ldc + col0;
#pragma unroll
                for (int bj = 0; bj < 2; ++bj) { f32x4 v0 = acc[ai][bj][m][0] + bv[bj][0], v1 = acc[ai][bj][m][1] + bv[bj][1];
                    if (ACT == 1) { f32x2 a = gelu_pk((f32x2){v0[0], v0[1]}), b = gelu_pk((f32x2){v0[2], v0[3]}), c = gelu_pk((f32x2){v1[0], v1[1]}), d = gelu_pk((f32x2){v1[2], v1[3]});
                        v0 = (f32x4){a.x, a.y, b.x, b.y}; v1 = (f32x4){c.x, c.y, d.x, d.y}; }
                    v0 = v0 * sc; v1 = v1 * sc; u32x4 w; w.x = cvt_pk_bf16(v0[0], v0[1]); w.y = cvt_pk_bf16(v0[2], v0[3]); w.z = cvt_pk_bf16(v1[0], v1[1]); w.w = cvt_pk_bf16(v1[2], v1[3]);
                    *(u32x4*)(rowp + bj * HALF) = w; } }
    }
};
template <class Epi, class Sched, bool ALIGN_EPI = false, bool SP2 = false>
__device__ __forceinline__ void gemm_phase(PG8_LAS unsigned char* lds, const Gemm g, const Sched& S, const Epi& E) {
    const int tid = threadIdx.x, wid = __builtin_amdgcn_readfirstlane(tid >> 6), lane = tid & 63, wr = wid >> 2, wc = wid & 3, fr = lane & 15, fq = lane >> 4;
    const int K = g.K, nt = K / BK;
    unsigned voffA[2], voffB[2];
#pragma unroll
    for (int i = 0; i < 2; ++i) { int R, C; stage_rc(tid * 16 + i * 8192, R, C); const int Rb = Epi::PERM ? ((R & ~31) + perm32(R & 31)) : R;
        voffA[i] = (unsigned)(R * K + C) * 2u; voffB[i] = (unsigned)(Rb * K + C) * 2u; }
    const size_t kstep = (size_t)(BK * 2);
    const size_t hstep = (size_t)HALF * K * 2;
    const size_t tstep = 2 * hstep;
    const unsigned ldsw = (unsigned)wid * 1024u;
    const int aoff = lds_byte(wr * 64 + fr, fq * 8), boff = lds_byte(wc * 32 + fr, fq * 8);
#define PG8_SA(b, h) (((b) * 2 + (h)) * HTB)
#define PG8_SB(b, h) ((4 + (b) * 2 + (h)) * HTB)
#define PG8_STAGE(bufoff, gbase, voff) do { _Pragma("unroll") for (int _i = 0; _i < 2; ++_i) \
        __builtin_amdgcn_global_load_lds((const unsigned*)((const char*)(gbase) + (voff)[_i]), (PG8_LAS unsigned*)(lds + (bufoff) + ldsw + _i * 8192), 16, 0, 0); } while (0)
#define PG8_LDA(dst, b, h) do { _Pragma("unroll") for (int m = 0; m < 4; ++m) _Pragma("unroll") for (int k = 0; k < 2; ++k) dst[m][k] = *(const PG8_LAS bf16x8*)(lds + PG8_SA(b, h) + aoff + m * 2048 + k * 1024); } while (0)
#define PG8_LDB(dst, b, h) do { _Pragma("unroll") for (int n = 0; n < 2; ++n) _Pragma("unroll") for (int k = 0; k < 2; ++k) dst[n][k] = *(const PG8_LAS bf16x8*)(lds + PG8_SB(b, h) + boff + n * 2048 + k * 1024); } while (0)
#define PG8_MMA(ai, bj, At, Bt) do { __builtin_amdgcn_s_setprio(1); _Pragma("unroll") for (int m = 0; m < 4; ++m) _Pragma("unroll") for (int n = 0; n < 2; ++n) _Pragma("unroll") for (int k = 0; k < 2; ++k) \
        acc[ai][bj][m][n] = __builtin_amdgcn_mfma_f32_16x16x32_bf16(Bt[n][k], At[m][k], acc[ai][bj][m][n], 0, 0, 0); __builtin_amdgcn_s_setprio(0); } while (0)
#define PG8_WAIT_V(n) asm volatile("s_waitcnt vmcnt(" #n ")" ::: "memory")
#define PG8_WAIT_L(n) asm volatile("s_waitcnt lgkmcnt(" #n ")" ::: "memory")
#define PG8_BAR __builtin_amdgcn_s_barrier()
#define PG8_SCHED __builtin_amdgcn_sched_barrier(0)
    Unit cur, nxt; int ui = 0;
    if (!S.next(0, cur)) return;
    f32x4 acc[2][2][4][2];
#pragma unroll
    for (int a = 0; a < 2; ++a)
#pragma unroll
        for (int b = 0; b < 2; ++b)
#pragma unroll
            for (int m = 0; m < 4; ++m)
#pragma unroll
                for (int n = 0; n < 2; ++n) acc[a][b][m][n] = (f32x4){0.f, 0.f, 0.f, 0.f};
    bf16x8 At[4][2], B0[2][2], B1[2][2];
    const char* cA = (const char*)g.A + (size_t)cur.pm * tstep; const char* cB = (const char*)g.Bt + (size_t)cur.pn * tstep;
    S.a_ready(cur);
    if constexpr (SP2) {
        PG8_STAGE(PG8_SB(0, 0), cB, voffB); PG8_STAGE(PG8_SB(0, 1), cB + hstep, voffB); PG8_STAGE(PG8_SA(0, 0), cA, voffA); PG8_STAGE(PG8_SA(0, 1), cA + hstep, voffA);
        if (wr == 1) PG8_BAR;
        PG8_WAIT_V(2); PG8_BAR;
        PG8_STAGE(PG8_SB(1, 0), cB + kstep, voffB); PG8_STAGE(PG8_SA(1, 0), cA + kstep, voffA); PG8_STAGE(PG8_SB(1, 1), cB + hstep + kstep, voffB);
        PG8_WAIT_V(6); PG8_BAR;
    } else {
        PG8_STAGE(PG8_SB(0, 0), cB, voffB); PG8_STAGE(PG8_SA(0, 0), cA, voffA); PG8_STAGE(PG8_SB(0, 1), cB + hstep, voffB); PG8_STAGE(PG8_SA(0, 1), cA + hstep, voffA);
        if (wr == 1) PG8_BAR;
        PG8_WAIT_V(4); PG8_BAR;
        PG8_STAGE(PG8_SB(1, 0), cB + kstep, voffB); PG8_STAGE(PG8_SA(1, 0), cA + kstep, voffA); PG8_STAGE(PG8_SB(1, 1), cB + hstep + kstep, voffB);
        PG8_WAIT_V(6); PG8_BAR;
    }
    for (;;) {
        const bool has_next = S.next(ui + 1, nxt);
        const char* nA = has_next ? (const char*)g.A + (size_t)nxt.pm * tstep : cA; const char* nB = has_next ? (const char*)g.Bt + (size_t)nxt.pn * tstep : cB;
        for (int t = 0; t < nt; t += 2) {
            const bool last = (t == nt - 2);
            const char* a1 = cA + (size_t)(t + 1) * kstep;
            const char* a2 = last ? nA : cA + (size_t)(t + 2) * kstep; const char* b2 = last ? nB : cB + (size_t)(t + 2) * kstep;
            const char* a3 = a2 + kstep; const char* b3 = b2 + kstep;
            if (last && has_next) S.a_ready(nxt);
            if constexpr (SP2) {
            PG8_LDB(B0, 0, 0); PG8_LDB(B1, 0, 1); PG8_SCHED; PG8_LDA(At, 0, 0); PG8_STAGE(PG8_SA(1, 1), a1 + hstep, voffA);
            PG8_WAIT_V(8); PG8_WAIT_L(0); PG8_BAR; PG8_MMA(0, 0, At, B0); PG8_MMA(0, 1, At, B1); PG8_BAR; PG8_SCHED;
            PG8_LDA(At, 0, 1); PG8_STAGE(PG8_SB(0, 0), b2, voffB); PG8_STAGE(PG8_SB(0, 1), b2 + hstep, voffB); PG8_STAGE(PG8_SA(0, 0), a2, voffA);
            PG8_WAIT_V(8); PG8_WAIT_L(0); PG8_BAR; PG8_MMA(1, 0, At, B0); PG8_MMA(1, 1, At, B1); PG8_BAR; PG8_SCHED;
            PG8_LDB(B0, 1, 0); PG8_LDB(B1, 1, 1); PG8_SCHED; PG8_LDA(At, 1, 0); PG8_STAGE(PG8_SA(0, 1), a2 + hstep, voffA);
            PG8_WAIT_V(8); PG8_WAIT_L(0); PG8_BAR; PG8_MMA(0, 0, At, B0); PG8_MMA(0, 1, At, B1); PG8_BAR; PG8_SCHED;
            PG8_LDA(At, 1, 1); PG8_STAGE(PG8_SB(1, 0), b3, voffB); PG8_STAGE(PG8_SB(1, 1), b3 + hstep, voffB); PG8_STAGE(PG8_SA(1, 0), a3, voffA);
            PG8_WAIT_V(8); PG8_WAIT_L(0); PG8_BAR; PG8_MMA(1, 0, At, B0); PG8_MMA(1, 1, At, B1); PG8_BAR; PG8_SCHED;
            } else {
            PG8_LDB(B0, 0, 0); PG8_SCHED; PG8_LDA(At, 0, 0); PG8_STAGE(PG8_SA(1, 1), a1 + hstep, voffA);
            PG8_WAIT_L(8); PG8_BAR; PG8_WAIT_L(0); PG8_MMA(0, 0, At, B0); PG8_BAR; PG8_SCHED;
            PG8_LDB(B1, 0, 1); PG8_STAGE(PG8_SB(0, 0), b2, voffB);
            PG8_BAR; PG8_WAIT_L(0); PG8_MMA(0, 1, At, B1); PG8_BAR;
            PG8_LDA(At, 0, 1); PG8_STAGE(PG8_SA(0, 0), a2, voffA);
            PG8_BAR; PG8_WAIT_L(0); PG8_MMA(1, 0, At, B0); PG8_BAR; PG8_SCHED;
            PG8_STAGE(PG8_SB(0, 1), b2 + hstep, voffB);
            PG8_WAIT_V(6); PG8_BAR; PG8_MMA(1, 1, At, B1); PG8_BAR;
            PG8_LDB(B0, 1, 0); PG8_SCHED; PG8_LDA(At, 1, 0); PG8_STAGE(PG8_SA(0, 1), a2 + hstep, voffA);
            PG8_WAIT_L(8); PG8_BAR; PG8_WAIT_L(0); PG8_MMA(0, 0, At, B0); PG8_BAR; PG8_SCHED;
            PG8_LDB(B1, 1, 1); PG8_STAGE(PG8_SB(1, 0), b3, voffB);
            PG8_BAR; PG8_WAIT_L(0); PG8_MMA(0, 1, At, B1); PG8_BAR;
            PG8_LDA(At, 1, 1); PG8_STAGE(PG8_SA(1, 0), a3, voffA);
            PG8_BAR; PG8_WAIT_L(0); PG8_MMA(1, 0, At, B0); PG8_BAR; PG8_SCHED;
            PG8_STAGE(PG8_SB(1, 1), b3 + hstep, voffB);
            PG8_WAIT_V(6); PG8_BAR; PG8_MMA(1, 1, At, B1); PG8_BAR;
            }
        }
        if constexpr (ALIGN_EPI) { if (wr == 0) PG8_BAR; }
        if constexpr (!Epi::AFTER_DRAIN) { E(acc, cur, wr, wc, fr, fq); S.done(cur); }
        if (!has_next) break;
#pragma unroll
        for (int a = 0; a < 2; ++a)
#pragma unroll
            for (int b = 0; b < 2; ++b)
#pragma unroll
                for (int m = 0; m < 4; ++m)
#pragma unroll
                    for (int n = 0; n < 2; ++n) acc[a][b][m][n] = (f32x4){0.f, 0.f, 0.f, 0.f};
        cur = nxt; cA = nA; cB = nB; ++ui;
        if constexpr (ALIGN_EPI) { if (wr == 1) PG8_BAR; }
    }
    PG8_WAIT_V(0);
    if constexpr (!ALIGN_EPI) { if (wr == 0) PG8_BAR; }
    PG8_BAR;
    if constexpr (Epi::AFTER_DRAIN) { E.fused(acc, cur, wr, wc, fr, fq, lds, wid, lane); S.done(cur); }
#undef PG8_SA
#undef PG8_SB
#undef PG8_STAGE
#undef PG8_LDA
#undef PG8_LDB
#undef PG8_MMA
#undef PG8_WAIT_V
#undef PG8_WAIT_L
#undef PG8_BAR
#undef PG8_SCHED
}
}

#ifndef PG8_SP2
#define PG8_SP2 true
#endif
#ifndef PG8_ALIGN
#define PG8_ALIGN true
#endif
#define GAS __attribute__((address_space(1)))
#define LAS __attribute__((address_space(3)))
typedef unsigned short bf16;
typedef unsigned v4u __attribute__((ext_vector_type(4)));
typedef float f32x4 __attribute__((ext_vector_type(4)));
typedef short bf16x8 __attribute__((ext_vector_type(8)));
typedef GAS unsigned gu32;
typedef GAS unsigned long long gu64;
#define RLX_AGENT __ATOMIC_RELAXED, __HIP_MEMORY_SCOPE_AGENT
#define LDS_WAIT() asm volatile("s_waitcnt lgkmcnt(0)" ::: "memory")
#define VM_WAIT() asm volatile("s_waitcnt vmcnt(0)" ::: "memory")
__device__ __forceinline__ unsigned long long rt() { return __builtin_amdgcn_s_memrealtime(); }
__device__ __forceinline__ unsigned f2bf(float f) { unsigned u = __builtin_bit_cast(unsigned, f); return (u + 0x7fffu + ((u >> 16) & 1u)) >> 16; }
__device__ __forceinline__ unsigned pk2(float lo, float hi) { return f2bf(lo) | (f2bf(hi) << 16); }

#define XB_TMO      128
#define XB_XCNT(j)  (256  + 64 * (j))
#define XB_XSUB(j)  (1280 + 64 * (j))
#define XB_XGEN(j)  (2304 + 64 * (j))
#define XB_TOP      3328
#define XB_TOPGEN   3392
#define XCD_BAR_WORDS 3456
#define XB_SPIN_CAP (1u << 18)

__device__ __forceinline__ unsigned xb_ld(unsigned* p)              { return __hip_atomic_load(p, __ATOMIC_RELAXED, __HIP_MEMORY_SCOPE_AGENT); }
__device__ __forceinline__ unsigned xb_add(unsigned* p, unsigned v) { return __hip_atomic_fetch_add(p, v, __ATOMIC_RELAXED, __HIP_MEMORY_SCOPE_AGENT); }
__device__ __forceinline__ unsigned xb_xcc_id() { return (unsigned)__builtin_amdgcn_s_getreg((3 << 11) | 20) & 0xFu; }
#define XB_SPIN(cond, bar) do { unsigned _sp = 0; while (cond) { __builtin_amdgcn_s_sleep(1); \
    if ((++_sp & 255u) == 0u) { if (xb_ld(&(bar)[XB_TMO])) break; if (_sp > XB_SPIN_CAP) { atomicAdd(&(bar)[XB_TMO], 1u); break; } } } } while (0)

struct XcdBarrier {
    unsigned* bar; unsigned x;
    volatile LAS unsigned* st;
};

__device__ __forceinline__ XcdBarrier xcd_barrier_post(unsigned* bar, volatile LAS unsigned* st) {
    XcdBarrier b; b.bar = bar; b.x = xb_xcc_id(); b.st = st;
    if (threadIdx.x == 0) (void)xb_add(&bar[XB_XCNT(b.x)], 1u);
    return b;
}
__device__ __forceinline__ void xcd_barrier_complete(unsigned* bar, unsigned x, unsigned& nloc, unsigned& nx) {
    const unsigned G = gridDim.x * gridDim.y * gridDim.z;
    unsigned sum, cnt, mine, sp = 0u;
    for (;;) {
        sum = 0u; cnt = 0u; mine = 0u;
#pragma unroll
        for (unsigned j = 0; j < 16; ++j) { const unsigned c = xb_ld(&bar[XB_XCNT(j)]); sum += c; cnt += (c > 0u) ? 1u : 0u; mine = (j == x) ? c : mine; }
        if (sum == G) break;
        __builtin_amdgcn_s_sleep(1);
        if ((++sp & 255u) == 0u) { if (xb_ld(&bar[XB_TMO])) break; if (sp > XB_SPIN_CAP) { atomicAdd(&bar[XB_TMO], 1u); break; } }
    }
    nloc = mine > 0u ? mine : 1u; nx = cnt > 0u ? cnt : 1u;
}

__device__ __forceinline__ void xcd_barrier(const XcdBarrier& b) {
    asm volatile("s_waitcnt vmcnt(0)" ::: "memory");
    __syncthreads();
    if (threadIdx.x == 0) {
        unsigned* bar = b.bar;
        __builtin_amdgcn_s_waitcnt(0);
        unsigned nloc = b.st[0], nx = b.st[1];
        if (nloc == 0u) { xcd_barrier_complete(bar, b.x, nloc, nx); b.st[0] = nloc; b.st[1] = nx; }
        const unsigned old = xb_add(&bar[XB_XSUB(b.x)], 1u);
        const unsigned gen = old / nloc;
        if (old + 1u == (gen + 1u) * nloc) {
            __builtin_amdgcn_fence(__ATOMIC_RELEASE, "agent");
            asm volatile("s_waitcnt vmcnt(0)" ::: "memory");
            const unsigned og = xb_add(&bar[XB_TOP], 1u);
            const unsigned tg = og / nx;
            if (og + 1u == (tg + 1u) * nx) xb_add(&bar[XB_TOPGEN], 1u);
            else XB_SPIN(xb_ld(&bar[XB_TOPGEN]) == tg, bar);
            __builtin_amdgcn_fence(__ATOMIC_ACQUIRE, "agent");
            xb_add(&bar[XB_XGEN(b.x)], 1u);
            asm volatile("s_waitcnt vmcnt(0)" ::: "memory");
        } else {
            XB_SPIN(xb_ld(&bar[XB_XGEN(b.x)]) == gen, bar);
            __builtin_amdgcn_fence(__ATOMIC_ACQUIRE, "agent");
            asm volatile("s_waitcnt vmcnt(0)" ::: "memory");
        }
    }
    __syncthreads();
}

constexpr int NWAVES = 8;
constexpr int T_ = 16384, D_ = 1024, INW = 4624, NP = 4864  ;
constexpr int NCH = 256  , MLH = 4, NAH = 8;
constexpr float EPS_ = 1e-6f;
constexpr int C_NAQ = 0, C_NAK = 512, C_NAV = 1024, C_NAZ = 1536, C_MLQ = 2048, C_MLK = 2560, C_MLV = 3072, C_MLO = 3584, C_MLZ = 4096, C_IF = 4608, C_FF = 4612, C_IB = 4616, C_FB = 4620;
#ifndef MK_N_LAUNCHES
#define MK_N_LAUNCHES 1
#endif
constexpr int N_PHASES = 8;
constexpr size_t MiB = 1u << 20;
constexpr size_t WS_CTL = 0, CTL_ZERO_BYTES = 64 * 1024;
constexpr size_t WS_MOD = 1 * MiB;
constexpr size_t WS_BIASP = WS_MOD + 16 * 1024;
constexpr size_t WS_BL = WS_MOD + 64 * 1024, WS_MLOC = WS_BL + 8192, WS_MPREV = WS_MLOC + 8192;
constexpr size_t WS_NVEC = 2 * MiB;
constexpr size_t WS_WT1 = 4 * MiB;
constexpr size_t WS_WT2 = 14 * MiB;
constexpr size_t WS_HMIX = 16 * MiB;
constexpr size_t WS_PROJ = 48 * MiB;
constexpr size_t WS_YBUF = 48 * MiB;
constexpr size_t WS_END = 200 * MiB;
constexpr int CW_BAR = 1024;
constexpr int LDS_BYTES = 147456, MISC_OFF = 147456 - 256;

struct Frame {
    LAS unsigned char* lds;
    volatile LAS unsigned* MISC;
    int tid, lane, wave, G;
    const float *x, *c, *w_ada, *b_ada, *norm_w, *w_in, *b_in, *conv_w, *conv_b, *rpb, *ml_norm_w, *w_out, *final_norm_w;
    float* out;
    float *mod, *biasp, *BL, *MLOC, *MPREV, *NVEC, *ybuf;
    bf16 *WT1, *WT2, *HMIX, *PROJ, *UC;
};

__device__ __forceinline__ float bf2f(unsigned short u) { return __uint_as_float(((unsigned)u) << 16); }
__device__ __forceinline__ float wave_sum(float v) {
#pragma unroll
    for (int o = 1; o < 64; o <<= 1) v += __shfl_xor(v, o);
    return v;
}
__device__ __forceinline__ float wave_max(float v) {
#pragma unroll
    for (int o = 1; o < 64; o <<= 1) v = fmaxf(v, __shfl_xor(v, o));
    return v;
}
__device__ __forceinline__ float rdlane(float v, int l) { return __int_as_float(__builtin_amdgcn_readlane(__float_as_int(v), l)); }
__device__ __forceinline__ float scan_sum(float v, int lane, int dir) {
#pragma unroll
    for (int o = 1; o < 64; o <<= 1) { const float up = __shfl_up(v, o), dn = __shfl_down(v, o); if (dir == 0) { if (lane >= o) v += up; } else { if (lane + o < 64) v += dn; } }
    return v;
}
__device__ __forceinline__ float scan_max(float v, int lane, int dir) {
#pragma unroll
    for (int o = 1; o < 64; o <<= 1) { const float up = __shfl_up(v, o), dn = __shfl_down(v, o); if (dir == 0) { if (lane >= o) v = fmaxf(v, up); } else { if (lane + o < 64) v = fmaxf(v, dn); } }
    return v;
}
__device__ __forceinline__ float logsigmoidf(float f) { return fminf(f, 0.f) - log1pf(expf(-fabsf(f))); }
__device__ __forceinline__ float siluf(float v) { return v / (1.f + expf(-v)); }
__host__ __device__ __forceinline__ int blob_idx(int e, int d) { const int et = e >> 4, ks = d >> 5, dd = d & 31, g = (dd & 15) >> 2, j = (dd & 3) + ((dd >> 4) << 2); return ((et * 4 + ks) * 64 + (e & 15) + 16 * g) * 8 + j; }

__device__ __forceinline__ void p0_mod(Frame& F) {
    LAS float* red = (LAS float*)F.lds;
    const int tid = F.tid;
    for (int blk = blockIdx.x; blk < 192; blk += F.G) {
        const int col = tid & 15, rg = tid >> 4, j = blk * 16 + col;
        float s = 0.f;
        for (int it = 0; it < 32; ++it) { const int i = rg + 32 * it; const float cv = F.c[i]; s += siluf(cv) * F.w_ada[(size_t)i * 3072 + j]; }
        red[rg * 16 + col] = s;
        __syncthreads();
        if (tid < 16) { float t = F.b_ada[blk * 16 + tid]; for (int r = 0; r < 32; ++r) t += red[r * 16 + tid]; F.mod[blk * 16 + tid] = t; }
        __syncthreads();
    }
    const int gt = blockIdx.x * (NWAVES * 64) + tid, NGT = F.G * NWAVES * 64;
    v4u* z = (v4u*)(F.WT1 + (size_t)INW * D_);
    for (int i = gt; i < (NP - INW) * D_ * 2 / 16; i += NGT) z[i] = (v4u){0u, 0u, 0u, 0u};
    for (int i = gt; i < NP; i += NGT) F.biasp[i] = i < INW ? F.b_in[i] : 0.f;
}

__device__ __forceinline__ void transpose_item(const float* W, int K, int N, bf16* WT, LAS float* scr, int item, int lane) {
    const int nblk = (N + 31) / 32, kb = item / nblk, nb = item % nblk, k0 = 64 * kb, n0 = 32 * nb;
#pragma unroll 8
    for (int i = 0; i < 32; ++i) { const int kk = 2 * i + (lane >> 5), n = n0 + (lane & 31); scr[kk * 33 + (lane & 31)] = n < N ? W[(size_t)(k0 + kk) * N + n] : 0.f; }
    LDS_WAIT(); asm volatile("" ::: "memory");
    const int c = lane & 7;
#pragma unroll
    for (int j = 0; j < 4; ++j) { const int n = (lane >> 3) + 8 * j; const LAS float* s = scr + (8 * c) * 33 + n;
        v4u o; o.x = pk2(s[0 * 33], s[1 * 33]); o.y = pk2(s[2 * 33], s[3 * 33]); o.z = pk2(s[4 * 33], s[5 * 33]); o.w = pk2(s[6 * 33], s[7 * 33]);
        *(GAS v4u*)(WT + (size_t)(n0 + n) * K + k0 + 8 * c) = o; }
    LDS_WAIT(); asm volatile("" ::: "memory");
}
__device__ __forceinline__ void p1_prep(Frame& F) {
    LAS float* scr = (LAS float*)(F.lds + F.wave * 16384);
    const int gw = blockIdx.x * NWAVES + F.wave, NGW = F.G * NWAVES;
    constexpr int I_1 = (D_ / 64) * ((INW + 31) / 32), I_2 = (D_ / 64) * (D_ / 32);
    for (int it = gw; it < I_1 + I_2; it += NGW) {
        if (it < I_1) transpose_item(F.w_in, D_, INW, F.WT1, scr, it, F.lane);
        else transpose_item(F.w_out, D_, D_, F.WT2, scr, it - I_1, F.lane);
    }
    f32x4 sc[4], sh[4];
#pragma unroll
    for (int j = 0; j < 4; ++j) { const int k = 4 * F.lane + 256 * j; const f32x4 nw = *(const f32x4*)(F.norm_w + k), scl = *(const f32x4*)(F.mod + 1024 + k); sh[j] = *(const f32x4*)(F.mod + k); sc[j] = nw * (scl + 1.0f); }
    for (int m = gw; m < T_; m += NGW) {
        const GAS f32x4* xr = (const GAS f32x4*)(F.x + (size_t)m * D_) + F.lane;
        f32x4 v[4]; float s = 0.f;
#pragma unroll
        for (int j = 0; j < 4; ++j) { v[j] = xr[64 * j]; s += (v[j].x * v[j].x + v[j].y * v[j].y) + (v[j].z * v[j].z + v[j].w * v[j].w); }
        const float rstd = 1.f / sqrtf(wave_sum(s) * (1.f / D_) + EPS_);
        GAS unsigned long long* o8 = (GAS unsigned long long*)(F.HMIX + (size_t)m * D_) + F.lane;
#pragma unroll
        for (int j = 0; j < 4; ++j) { const f32x4 h = v[j] * rstd * sc[j] + sh[j]; o8[64 * j] = (unsigned long long)pk2(h.x, h.y) | ((unsigned long long)pk2(h.z, h.w) << 32); }
    }
}

__device__ __forceinline__ void na_slow(Frame& F) {
    const int gw = blockIdx.x * NWAVES + F.wave, NGW = F.G * NWAVES, lane = F.lane;
    for (int task = gw; task < T_ * NAH; task += NGW) {
        const int c = task & 63, hh = (task >> 6) & 7, r = task >> 9, t = r * 64 + c;
        const int rs = min(max(r - 4, 0), NCH - 8), cs = min(max(c - 8, 0), 48);
        const bf16* prow = F.PROJ + (size_t)t * NP;
        const float qv = bf2f(prow[C_NAQ + hh * 64 + lane]) * 0.125f;
        const int j0 = lane >> 4, xo = lane & 15;
        const int tok0 = (rs + j0) * 64 + cs + xo, tok1 = tok0 + 4 * 64;
        const v4u* k0p = (const v4u*)(F.PROJ + (size_t)tok0 * NP + C_NAK + hh * 64);
        const v4u* k1p = (const v4u*)(F.PROJ + (size_t)tok1 * NP + C_NAK + hh * 64);
        float s0 = 0.f, s1 = 0.f;
#pragma unroll
        for (int ch = 0; ch < 8; ++ch) {
            const v4u a = k0p[ch], b = k1p[ch];
#pragma unroll
            for (int e = 0; e < 4; ++e) {
                const float q0 = rdlane(qv, ch * 8 + 2 * e), q1 = rdlane(qv, ch * 8 + 2 * e + 1);
                s0 += q0 * __uint_as_float(a[e] << 16) + q1 * __uint_as_float(a[e] & 0xffff0000u);
                s1 += q0 * __uint_as_float(b[e] << 16) + q1 * __uint_as_float(b[e] & 0xffff0000u);
            }
        }
        const int dx = cs + xo - c + 15;
        s0 += F.rpb[(hh * 15 + (rs + j0 - r + 7)) * 31 + dx];
        s1 += F.rpb[(hh * 15 + (rs + j0 + 4 - r + 7)) * 31 + dx];
        const float m = wave_max(fmaxf(s0, s1));
        float p0 = expf(s0 - m), p1 = expf(s1 - m);
        const float inv = 1.f / wave_sum(p0 + p1);
        p0 *= inv; p1 *= inv;
        float o = 0.f;
        const bf16* vb = F.PROJ + C_NAV + hh * 64 + lane;
#pragma unroll
        for (int kk = 0; kk < 64; ++kk) {
            const int tk = (rs + (kk >> 4)) * 64 + cs + (kk & 15);
            o += rdlane(p0, kk) * bf2f(vb[(size_t)tk * NP]) + rdlane(p1, kk) * bf2f(vb[(size_t)(tk + 256) * NP]);
        }
        const float z = bf2f(prow[C_NAZ + hh * 64 + lane]);
        F.HMIX[(size_t)t * D_ + hh * 64 + lane] = (bf16)f2bf(o * siluf(z));
    }
}

__device__ __forceinline__ float conv_silu(const Frame& F, int tok, int ch) {
    float acc = F.conv_b[ch];
#pragma unroll
    for (int j = 0; j < 5; ++j) { const int tt = tok + j - 2; if (tt >= 0 && tt < T_) acc += bf2f(F.PROJ[(size_t)tt * NP + C_MLQ + ch]) * F.conv_w[j * 1024 + ch]; }
    return siluf(acc);
}

__device__ __forceinline__ void mlA_slow(Frame& F) {
    LAS float* kc = (LAS float*)F.lds;
    LAS float* vv = kc + 64 * 128;
    LAS float* wt = vv + 64 * 128;
    const int tid = F.tid, lane = F.lane;
    for (int unit = blockIdx.x; unit < NCH * MLH; unit += F.G) {
        const int chunk = unit >> 2, hh = unit & 3, tok0 = chunk * 64;
        if (F.wave < 2) {
            const int dir = F.wave, ub = unit * 2 + dir;
            const bf16* pr = F.PROJ + (size_t)(tok0 + lane) * NP;
            const float f = bf2f(pr[(dir ? C_FB : C_FF) + hh]), ig = bf2f(pr[(dir ? C_IB : C_IF) + hh]);
            const float b = scan_sum(logsigmoidf(f), lane, dir);
            const float bl = rdlane(b, dir ? 0 : 63);
            const float a = bl - b + ig;
            const float mloc = wave_max(a);
            wt[dir * 64 + lane] = expf(a - mloc);
            if (lane == 0) { F.BL[ub] = bl; F.MLOC[ub] = mloc; }
        }
        for (int idx = tid; idx < 64 * 128; idx += NWAVES * 64) {
            const int s = idx >> 7, d = idx & 127;
            kc[idx] = conv_silu(F, tok0 + s, 512 + hh * 128 + d) * 0.08838834764831845f;
            vv[idx] = bf2f(F.PROJ[(size_t)(tok0 + s) * NP + C_MLV + hh * 128 + d]);
        }
        __syncthreads();
        const int d = tid & 127, eg = tid >> 7;
#pragma unroll 1
        for (int dir = 0; dir < 2; ++dir) {
            const int ub = unit * 2 + dir;
            float acc[32];
#pragma unroll
            for (int i = 0; i < 32; ++i) acc[i] = 0.f;
#pragma unroll 2
            for (int s = 0; s < 64; ++s) {
                const float kd = kc[s * 128 + d] * wt[dir * 64 + s];
#pragma unroll
                for (int i = 0; i < 32; ++i) acc[i] += kd * vv[s * 128 + eg * 32 + i];
            }
            bf16* ub_p = F.UC + (size_t)ub * 16384;
#pragma unroll
            for (int i = 0; i < 32; ++i) ub_p[blob_idx(eg * 32 + i, d)] = (bf16)f2bf(acc[i]);
        }
        if (tid < 256) { const int dir = tid >> 7, dd = tid & 127; float n = 0.f; for (int s = 0; s < 64; ++s) n += wt[dir * 64 + s] * kc[s * 128 + dd]; F.NVEC[(size_t)(unit * 2 + dir) * 128 + dd] = n; }
        __syncthreads();
    }
}

__device__ __forceinline__ void ml_scan(Frame& F) {
    LAS float* dec = (LAS float*)F.lds;
    LAS float* scl = dec + 256;
    LAS float* tb = scl + 256;
    const int tid = F.tid;
    for (int w = blockIdx.x; w < 256; w += F.G) {
        const int stream = w & 7, slice = w >> 3, hh = stream >> 1, dir = stream & 1;
        if (tid < 256) { const int chunk = dir ? 255 - tid : tid, ub = (chunk * 4 + hh) * 2 + dir; tb[tid] = F.BL[ub]; tb[256 + tid] = F.MLOC[ub]; }
        __syncthreads();
        if (tid == 0) {
            float m = 0.f;
            for (int st = 0; st < 256; ++st) {
                const int chunk = dir ? 255 - st : st, ub = (chunk * 4 + hh) * 2 + dir;
                const float bl = tb[st], ml = tb[256 + st], mn = fmaxf(bl + m, ml);
                dec[st] = expf(bl + m - mn); scl[st] = expf(ml - mn);
                if (slice == 0) F.MPREV[ub] = m;
                m = mn;
            }
        }
        __syncthreads();
        {
            const int elem = slice * 512 + tid;
            float C = 0.f;
            bf16* base = F.UC + elem;
            for (int st0 = 0; st0 < 256; st0 += 16) {
                float u[16];
#pragma unroll
                for (int k = 0; k < 16; ++k) { const int st = st0 + k, chunk = dir ? 255 - st : st, ub = (chunk * 4 + hh) * 2 + dir; u[k] = bf2f(base[(size_t)ub * 16384]); }
#pragma unroll
                for (int k = 0; k < 16; ++k) { const int st = st0 + k, chunk = dir ? 255 - st : st, ub = (chunk * 4 + hh) * 2 + dir; base[(size_t)ub * 16384] = (bf16)f2bf(C); C = dec[st] * C + scl[st] * u[k]; }
            }
        }
        if (slice == 1 && tid < 128) {
            float n = 0.f;
            for (int st = 0; st < 256; ++st) { const int chunk = dir ? 255 - st : st, ub = (chunk * 4 + hh) * 2 + dir; float* p = F.NVEC + (size_t)ub * 128 + tid; const float u = *p; *p = n; n = dec[st] * n + scl[st] * u; }
        }
        __syncthreads();
    }
}

__device__ __forceinline__ void mlO_slow(Frame& F) {
    constexpr int LD = 129;
    LAS float* qc = (LAS float*)F.lds;
    LAS float* kc = qc + 64 * LD;
    LAS float* vv = kc + 64 * LD;
    LAS float* S = vv + 64 * 128;
    LAS float* ga = S + 64 * 65;
    const int tid = F.tid, lane = F.lane;
    for (int unit = blockIdx.x; unit < NCH * MLH; unit += F.G) {
        const int chunk = unit >> 2, hh = unit & 3, tok0 = chunk * 64;
        if (F.wave < 2) {
            const int dir = F.wave, ub = unit * 2 + dir;
            const bf16* pr = F.PROJ + (size_t)(tok0 + lane) * NP;
            const float f = bf2f(pr[(dir ? C_FB : C_FF) + hh]), ig = bf2f(pr[(dir ? C_IB : C_IF) + hh]);
            const float b = scan_sum(logsigmoidf(f), lane, dir);
            const float u = ig - b;
            const float pm = scan_max(u, lane, dir);
            const float mp = F.MPREV[ub];
            const float M = fmaxf(mp, pm);
            LAS float* g = ga + dir * 320;
            g[lane] = u; g[64 + lane] = M; g[128 + lane] = expf(mp - M); g[192 + lane] = expf(-(b + M));
        }
        for (int idx = tid; idx < 64 * 128; idx += NWAVES * 64) {
            const int s = idx >> 7, d = idx & 127;
            qc[s * LD + d] = conv_silu(F, tok0 + s, hh * 128 + d);
            kc[s * LD + d] = conv_silu(F, tok0 + s, 512 + hh * 128 + d) * 0.08838834764831845f;
            vv[idx] = bf2f(F.PROJ[(size_t)(tok0 + s) * NP + C_MLV + hh * 128 + d]);
        }
        __syncthreads();
        float hsum[16];
#pragma unroll
        for (int i = 0; i < 16; ++i) hsum[i] = 0.f;
#pragma unroll 1
        for (int dir = 0; dir < 2; ++dir) {
            const int ub = unit * 2 + dir;
            LAS float* g = ga + dir * 320;
            {
                const int s = tid & 63, tg = tid >> 6;
                float acc[8];
#pragma unroll
                for (int j = 0; j < 8; ++j) acc[j] = 0.f;
                for (int d = 0; d < 128; ++d) { const float kv = kc[s * LD + d];
#pragma unroll
                    for (int j = 0; j < 8; ++j) acc[j] += kv * qc[(tg * 8 + j) * LD + d]; }
                const float us = g[s];
#pragma unroll
                for (int j = 0; j < 8; ++j) { const int t = tg * 8 + j; const bool ok = dir ? (s >= t) : (s <= t); S[t * 65 + s] = ok ? acc[j] * expf(fminf(us - g[64 + t], 0.f)) : 0.f; }
            }
            __syncthreads();
            if (tid < 64) {
                const int t = tid; float rs = 0.f, nq = 0.f;
                for (int s = 0; s < 64; ++s) rs += S[t * 65 + s];
                for (int d = 0; d < 128; ++d) nq += F.NVEC[(size_t)ub * 128 + d] * qc[t * LD + d];
                const float den = rs + g[128 + t] * nq;
                g[256 + t] = 1.f / fmaxf(fabsf(den), g[192 + t]);
            }
            {
                const int e = tid & 127, tg = tid >> 7;
                float acc[16];
#pragma unroll
                for (int i = 0; i < 16; ++i) acc[i] = 0.f;
                const v4u* cb = (const v4u*)(F.UC + (size_t)ub * 16384);
#pragma unroll
                for (int ks = 0; ks < 4; ++ks)
#pragma unroll
                    for (int gq = 0; gq < 4; ++gq) {
                        const v4u cv = cb[((e >> 4) * 4 + ks) * 64 + (e & 15) + 16 * gq];
#pragma unroll
                        for (int j = 0; j < 8; ++j) {
                            const int d = 32 * ks + (j < 4 ? 4 * gq + j : 16 + 4 * gq + (j - 4));
                            const unsigned wv = cv[j >> 1];
                            const float cval = (j & 1) ? __uint_as_float(wv & 0xffff0000u) : __uint_as_float(wv << 16);
#pragma unroll
                            for (int i = 0; i < 16; ++i) acc[i] += cval * qc[(tg * 16 + i) * LD + d];
                        }
                    }
#pragma unroll
                for (int i = 0; i < 16; ++i) acc[i] *= g[128 + tg * 16 + i];
                for (int s = 0; s < 64; ++s) { const float ve = vv[s * 128 + e];
#pragma unroll
                    for (int i = 0; i < 16; ++i) acc[i] += S[(tg * 16 + i) * 65 + s] * ve; }
                __syncthreads();
#pragma unroll
                for (int i = 0; i < 16; ++i) hsum[i] += acc[i] * g[256 + tg * 16 + i];
            }
            __syncthreads();
        }
        {
            const int e = tid & 127, tg = tid >> 7;
#pragma unroll
            for (int i = 0; i < 16; ++i) { const int t = tg * 16 + i; const float o = bf2f(F.PROJ[(size_t)(tok0 + t) * NP + C_MLO + hh * 128 + e]); qc[t * 128 + e] = hsum[i] / (1.f + expf(-o)); }
            __syncthreads();
#pragma unroll 1
            for (int r = 0; r < 8; ++r) {
                const int t = F.wave * 8 + r;
                const float a = qc[t * 128 + lane], b = qc[t * 128 + 64 + lane];
                const float mu = wave_sum(a + b) * (1.f / 128.f);
                const float da = a - mu, db = b - mu;
                const float rstd = 1.f / sqrtf(wave_sum(da * da + db * db) * (1.f / 128.f) + EPS_);
                const bf16* pz = F.PROJ + (size_t)(tok0 + t) * NP + C_MLZ + hh * 128;
                bf16* po = F.HMIX + (size_t)(tok0 + t) * D_ + 512 + hh * 128;
                po[lane] = (bf16)f2bf(da * rstd * F.ml_norm_w[hh * 128 + lane] * siluf(bf2f(pz[lane])));
                po[64 + lane] = (bf16)f2bf(db * rstd * F.ml_norm_w[hh * 128 + 64 + lane] * siluf(bf2f(pz[64 + lane])));
            }
        }
        __syncthreads();
    }
}

struct EpiResGate {
    static constexpr bool PERM = false, AFTER_DRAIN = false;
    const float* x; const float* gate; float* y;
    __device__ __forceinline__ void operator()(const pg8::f32x4 (&acc)[2][2][4][2], const pg8::Unit& u, int wr, int wc, int fr, int fq) const {
        const int col0 = u.pn * 256 + wc * 32 + 4 * fq;
#pragma unroll
        for (int bj = 0; bj < 2; ++bj)
#pragma unroll
            for (int n = 0; n < 2; ++n) { const f32x4 g4 = *(const f32x4*)(gate + col0 + bj * 128 + n * 16);
#pragma unroll
                for (int ai = 0; ai < 2; ++ai)
#pragma unroll
                    for (int m = 0; m < 4; ++m) { const size_t off = (size_t)(u.pm * 256 + ai * 128 + wr * 64 + m * 16 + fr) * D_ + col0 + bj * 128 + n * 16;
                        const f32x4 xv = *(const f32x4*)(x + off); *(f32x4*)(y + off) = xv + g4 * acc[ai][bj][m][n]; } }
    }
};

__device__ __forceinline__ void p7_final(Frame& F) {
    const int gw = blockIdx.x * NWAVES + F.wave, NGW = F.G * NWAVES;
    f32x4 fw[4];
#pragma unroll
    for (int j = 0; j < 4; ++j) fw[j] = *(const f32x4*)(F.final_norm_w + 4 * F.lane + 256 * j);
    for (int m = gw; m < T_; m += NGW) {
        const GAS f32x4* yr = (const GAS f32x4*)(F.ybuf + (size_t)m * D_) + F.lane;
        f32x4 v[4]; float s = 0.f;
#pragma unroll
        for (int j = 0; j < 4; ++j) { v[j] = yr[64 * j]; s += (v[j].x * v[j].x + v[j].y * v[j].y) + (v[j].z * v[j].z + v[j].w * v[j].w); }
        const float rstd = 1.f / sqrtf(wave_sum(s) * (1.f / D_) + EPS_);
        GAS f32x4* o = (GAS f32x4*)(F.out + (size_t)m * D_) + F.lane;
#pragma unroll
        for (int j = 0; j < 4; ++j) o[64 * j] = v[j] * rstd * fw[j];
    }
}

struct Args { const float* in[13]; float* out; unsigned char* ws; int ph_lo, ph_hi; };
__global__ void __launch_bounds__(NWAVES * 64, 2) mk_fwd(Args args) {
    extern __shared__ __attribute__((aligned(16))) unsigned char lds[];
    Frame F;
    F.lds = (LAS unsigned char*)lds;
    F.MISC = (volatile LAS unsigned*)(F.lds + MISC_OFF);
    F.tid = threadIdx.x; F.lane = F.tid & 63; F.wave = __builtin_amdgcn_readfirstlane(F.tid >> 6); F.G = gridDim.x;
    unsigned char* ws = args.ws;
    F.x = args.in[0]; F.c = args.in[1]; F.w_ada = args.in[2]; F.b_ada = args.in[3]; F.norm_w = args.in[4]; F.w_in = args.in[5]; F.b_in = args.in[6];
    F.conv_w = args.in[7]; F.conv_b = args.in[8]; F.rpb = args.in[9]; F.ml_norm_w = args.in[10]; F.w_out = args.in[11]; F.final_norm_w = args.in[12];
    F.out = args.out;
    F.mod = (float*)(ws + WS_MOD); F.biasp = (float*)(ws + WS_BIASP); F.BL = (float*)(ws + WS_BL); F.MLOC = (float*)(ws + WS_MLOC); F.MPREV = (float*)(ws + WS_MPREV);
    F.NVEC = (float*)(ws + WS_NVEC); F.ybuf = (float*)(ws + WS_YBUF);
    F.WT1 = (bf16*)(ws + WS_WT1); F.WT2 = (bf16*)(ws + WS_WT2); F.HMIX = (bf16*)(ws + WS_HMIX); F.PROJ = (bf16*)(ws + WS_PROJ); F.UC = (bf16*)args.out;
    for (int u = F.tid; u < 64; u += NWAVES * 64) ((LAS unsigned*)(F.lds + MISC_OFF))[u] = 0u;
    __syncthreads();
    const int lo = args.ph_lo, hi = args.ph_hi;
    const bool one = (hi - lo) > 1;
    XcdBarrier bar; bar.bar = (unsigned*)(ws + WS_CTL) + CW_BAR; bar.x = 0; bar.st = nullptr;
    if (one) bar = xcd_barrier_post((unsigned*)(ws + WS_CTL) + CW_BAR, F.MISC + 8);
#define IN(k) (lo <= (k) && (k) < hi)
#define SEAM(k) do { if (IN(k) && IN((k) + 1)) xcd_barrier(bar); } while (0)
    if (IN(0)) { p0_mod(F); } SEAM(0);
    if (IN(1)) { p1_prep(F); } SEAM(1);
    if (IN(2)) {
        pg8::Gemm g{F.HMIX, F.WT1, T_, NP, D_}; pg8::StaticOrder S; S.init(T_, NP, F.G, (int)blockIdx.x);
        pg8::EpiBf16<0> E{F.PROJ, NP, F.biasp, 0, 0, 1.f};
        pg8::gemm_phase<pg8::EpiBf16<0>, pg8::StaticOrder, PG8_ALIGN, PG8_SP2>(F.lds, g, S, E);
    } SEAM(2);
    if (IN(3)) { na_slow(F); mlA_slow(F); } SEAM(3);
    if (IN(4)) { ml_scan(F); } SEAM(4);
    if (IN(5)) { mlO_slow(F); } SEAM(5);
    if (IN(6)) {
        pg8::Gemm g{F.HMIX, F.WT2, T_, D_, D_}; pg8::StaticOrder S; S.init(T_, D_, F.G, (int)blockIdx.x);
        EpiResGate E{F.x, F.mod + 2048, F.ybuf};
        pg8::gemm_phase<EpiResGate, pg8::StaticOrder, false, PG8_SP2>(F.lds, g, S, E);
    } SEAM(6);
    if (IN(7)) { p7_final(F); }
#undef IN
#undef SEAM
}

extern "C" void kernel_launch(void* const* d_in, const int* in_sizes, int n_in, void* d_out, int out_size, void* d_ws, size_t ws_size, hipStream_t stream) {
    static int grid = 0;
    if (grid == 0) {
        if (n_in != 13 || in_sizes[0] != T_ * D_ || out_size != T_ * D_ || ws_size < WS_END) { fprintf(stderr, "kernel_launch: unexpected shapes (n_in %d, in0 %d, out %d, ws %zu); nothing launched\n", n_in, n_in > 0 ? in_sizes[0] : -1, out_size, ws_size); grid = -1; return; }
        int dev = 0, cus = 0, per_cu = 0;
        if (hipGetDevice(&dev) != hipSuccess || hipDeviceGetAttribute(&cus, hipDeviceAttributeMultiprocessorCount, dev) != hipSuccess) { grid = -1; return; }
        if (hipFuncSetAttribute((const void*)mk_fwd, hipFuncAttributeMaxDynamicSharedMemorySize, LDS_BYTES) != hipSuccess) { fprintf(stderr, "kernel_launch: hipFuncSetAttribute failed\n"); grid = -1; return; }
        if (hipOccupancyMaxActiveBlocksPerMultiprocessor(&per_cu, (const void*)mk_fwd, NWAVES * 64, LDS_BYTES) != hipSuccess || per_cu < 1) { fprintf(stderr, "kernel_launch: occupancy query says %d blocks per CU; nothing launched\n", per_cu); grid = -1; return; }
        (void)hipGetLastError();
        grid = cus;
    }
    if (grid < 0) return;
    (void)hipMemsetAsync((char*)d_ws + WS_CTL, 0, CTL_ZERO_BYTES, stream);
    Args a{};
    for (int i = 0; i < 13; ++i) a.in[i] = (const float*)d_in[i];
    a.out = (float*)d_out; a.ws = (unsigned char*)d_ws;
#if MK_N_LAUNCHES == 1
    a.ph_lo = 0; a.ph_hi = N_PHASES;
    hipLaunchKernelGGL(mk_fwd, dim3(grid), dim3(NWAVES * 64), LDS_BYTES, stream, a);
#else
    for (int p = 0; p < N_PHASES; ++p) { a.ph_lo = p; a.ph_hi = p + 1; hipLaunchKernelGGL(mk_fwd, dim3(grid), dim3(NWAVES * 64), LDS_BYTES, stream, a); }
#endif
}
```

```cpp
#define MK_N_LAUNCHES 1
#include <hip/hip_runtime.h>
#include <cstdio>
#include <cstdint>
namespace pg8 {
#define PG8_LAS __attribute__((address_space(3)))
typedef unsigned short bf16_t;
typedef short bf16x8 __attribute__((ext_vector_type(8)));
typedef float f32x4 __attribute__((ext_vector_type(4)));
typedef unsigned u32x4 __attribute__((ext_vector_type(4)));
constexpr int BM = 256, BK = 64, HALF = 128, HTB = HALF * BK * 2  , STAGE_BYTES = 8 * HTB, NXCD = 8, WGM = 8;

__host__ __device__ __forceinline__ int lds_byte(int r, int c) { const int st = (r >> 4) * 2 + (c >> 5), rr = r & 15, cc = c & 31, ob = rr * 64 + cc * 2; return st * 1024 + (ob ^ (((ob >> 9) & 1) << 5)); }
__host__ __device__ __forceinline__ void stage_rc(int b, int& R, int& C) { const int st = b / 1024, sb = b % 1024, swz = sb ^ (((sb >> 9) & 1) << 5); R = (st >> 1) * 16 + swz / 64; C = (st & 1) * 32 + (swz % 64) / 2; }
__host__ __device__ __forceinline__ int perm32(int rho) { const int n = rho >> 4, i = rho & 15; return 8 * (i >> 2) + 4 * n + (i & 3); }

struct Unit { int pm, pn; };
struct Gemm { const bf16_t* A; const bf16_t* Bt; int M, N, K; };

struct StaticOrder {
    int nM, nN, nwg, G, c;
    __host__ __device__ void init(int M, int N, int G_, int c_) { nM = M / BM; nN = N / BM; nwg = nM * nN; G = G_; c = c_; }
    __host__ __device__ bool next(int i, Unit& u) const {
        const long L = (long)i * G + c; if (L >= nwg) return false;
        int wgid = (int)L; { const int q = nwg / NXCD, r = nwg % NXCD, xcd = wgid % NXCD, off = wgid / NXCD; wgid = (xcd < r ? xcd * (q + 1) : r * (q + 1) + (xcd - r) * q) + off; }
        const int nig = WGM * nN, gid = wgid / nig, fm = gid * WGM, gsz = (nM - fm) < WGM ? (nM - fm) : WGM;
        u.pm = fm + ((wgid % nig) % gsz); u.pn = (wgid % nig) / gsz; return true;
    }
    __device__ __forceinline__ void a_ready(const Unit&) const {}
    __device__ __forceinline__ void done(const Unit&) const {}
};

__device__ __forceinline__ unsigned cvt_pk_bf16(float lo, float hi) { unsigned r; asm volatile("v_cvt_pk_bf16_f32 %0, %1, %2" : "=v"(r) : "v"(lo), "v"(hi)); return r; }
typedef float f32x2 __attribute__((ext_vector_type(2)));
__device__ __forceinline__ f32x2 gelu_pk(f32x2 v) {
    const f32x2 av = __builtin_elementwise_abs(v), d = av * 0.2316418882f + 1.0f;
    f32x2 t; t.x = __builtin_amdgcn_rcpf(d.x); t.y = __builtin_amdgcn_rcpf(d.y);
    f32x2 q = t * 0.5307027145f + (-0.7265760135f); q = q * t + 0.7107068705f; q = q * t + (-0.142248368f); q = q * t + 0.127414796f; q = q * t;
    const f32x2 s = (v * v) * (-0.72134752044f);
    f32x2 e; e.x = __builtin_amdgcn_exp2f(s.x); e.y = __builtin_amdgcn_exp2f(s.y);
    const f32x2 m = v * (q * e), r = v - m;
    f32x2 o; o.x = v.x < 0.f ? m.x : r.x; o.y = v.y < 0.f ? m.y : r.y; return o;
}

template <int ACT  > struct EpiBf16 {
    static constexpr bool PERM = true, AFTER_DRAIN = false; static_assert(ACT == 0 || ACT == 1, "EpiBf16: ACT is 0 (none) or 1 (gelu_pk)");
    bf16_t* O; int ldc; const float* bias; int split_cols; size_t split_stride; float scale0;
    __device__ __forceinline__ void operator()(const f32x4 (&acc)[2][2][4][2], const Unit& u, int wr, int wc, int fr, int fq) const {
        const int row0 = u.pm * BM + wr * 64 + fr; int colt = u.pn * BM; bf16_t* base = O;
        float sc = 1.f; if (split_cols) { const int t = colt / split_cols; base += (size_t)t * split_stride; colt -= t * split_cols; if (t == 0) sc = scale0; }
        const int col0 = colt + wc * 32 + 8 * fq, bcol0 = u.pn * BM + wc * 32 + 8 * fq;
        f32x4 bv[2][2];
#pragma unroll
        for (int bj = 0; bj < 2; ++bj)
#pragma unroll
            for (int n = 0; n < 2; ++n) bv[bj][n] = bias ? *(const f32x4*)(bias + bcol0 + bj * HALF + 4 * n) : (f32x4){0.f, 0.f, 0.f, 0.f};
#pragma unroll
        for (int ai = 0; ai < 2; ++ai)
#pragma unroll
            for (int m = 0; m < 4; ++m) { bf16_t* rowp = base + (size_t)(row0 + ai * HALF + m * 16) * ldc + col0;
#pragma unroll
                for (int bj = 0; bj < 2; ++bj) { f32x4 v0 = acc[ai][bj][m][0] + bv[bj][0], v1 = acc[ai][bj][m][1] + bv[bj][1];
                    if (ACT == 1) { f32x2 a = gelu_pk((f32x2){v0[0], v0[1]}), b = gelu_pk((f32x2){v0[2], v0[3]}), c = gelu_pk((f32x2){v1[0], v1[1]}), d = gelu_pk((f32x2){v1[2], v1[3]});
                        v0 = (f32x4){a.x, a.y, b.x, b.y}; v1 = (f32x4){c.x, c.y, d.x, d.y}; }
                    v0 = v0 * sc; v1 = v1 * sc; u32x4 w; w.x = cvt_pk_bf16(v0[0], v0[1]); w.y = cvt_pk_bf16(v0[2], v0[3]); w.z = cvt_pk_bf16(v1[0], v1[1]); w.w = cvt_pk_bf16(v1[2], v1[3]);
                    *(u32x4*)(rowp + bj * HALF) = w; } }
    }
};
template <class Epi, class Sched, bool ALIGN_EPI = false, bool SP2 = false>
__device__ __forceinline__ void gemm_phase(PG8_LAS unsigned char* lds, const Gemm g, const Sched& S, const Epi& E) {
    const int tid = threadIdx.x, wid = __builtin_amdgcn_readfirstlane(tid >> 6), lane = tid & 63, wr = wid >> 2, wc = wid & 3, fr = lane & 15, fq = lane >> 4;
    const int K = g.K, nt = K / BK;
    unsigned voffA[2], voffB[2];
#pragma unroll
    for (int i = 0; i < 2; ++i) { int R, C; stage_rc(tid * 16 + i * 8192, R, C); const int Rb = Epi::PERM ? ((R & ~31) + perm32(R & 31)) : R;
        voffA[i] = (unsigned)(R * K + C) * 2u; voffB[i] = (unsigned)(Rb * K + C) * 2u; }
    const size_t kstep = (size_t)(BK * 2);
    const size_t hstep = (size_t)HALF * K * 2;
    const size_t tstep = 2 * hstep;
    const unsigned ldsw = (unsigned)wid * 1024u;
    const int aoff = lds_byte(wr * 64 + fr, fq * 8), boff = lds_byte(wc * 32 + fr, fq * 8);
#define PG8_SA(b, h) (((b) * 2 + (h)) * HTB)
#define PG8_SB(b, h) ((4 + (b) * 2 + (h)) * HTB)
#define PG8_STAGE(bufoff, gbase, voff) do { _Pragma("unroll") for (int _i = 0; _i < 2; ++_i) \
        __builtin_amdgcn_global_load_lds((const unsigned*)((const char*)(gbase) + (voff)[_i]), (PG8_LAS unsigned*)(lds + (bufoff) + ldsw + _i * 8192), 16, 0, 0); } while (0)
#define PG8_LDA(dst, b, h) do { _Pragma("unroll") for (int m = 0; m < 4; ++m) _Pragma("unroll") for (int k = 0; k < 2; ++k) dst[m][k] = *(const PG8_LAS bf16x8*)(lds + PG8_SA(b, h) + aoff + m * 2048 + k * 1024); } while (0)
#define PG8_LDB(dst, b, h) do { _Pragma("unroll") for (int n = 0; n < 2; ++n) _Pragma("unroll") for (int k = 0; k < 2; ++k) dst[n][k] = *(const PG8_LAS bf16x8*)(lds + PG8_SB(b, h) + boff + n * 2048 + k * 1024); } while (0)
#define PG8_MMA(ai, bj, At, Bt) do { __builtin_amdgcn_s_setprio(1); _Pragma("unroll") for (int m = 0; m < 4; ++m) _Pragma("unroll") for (int n = 0; n < 2; ++n) _Pragma("unroll") for (int k = 0; k < 2; ++k) \
        acc[ai][bj][m][n] = __builtin_amdgcn_mfma_f32_16x16x32_bf16(Bt[n][k], At[m][k], acc[ai][bj][m][n], 0, 0, 0); __builtin_amdgcn_s_setprio(0); } while (0)
#define PG8_WAIT_V(n) asm volatile("s_waitcnt vmcnt(" #n ")" ::: "memory")
#define PG8_WAIT_L(n) asm volatile("s_waitcnt lgkmcnt(" #n ")" ::: "memory")
#define PG8_BAR __builtin_amdgcn_s_barrier()
#define PG8_SCHED __builtin_amdgcn_sched_barrier(0)
    Unit cur, nxt; int ui = 0;
    if (!S.next(0, cur)) return;
    f32x4 acc[2][2][4][2];
#pragma unroll
    for (int a = 0; a < 2; ++a)
#pragma unroll
        for (int b = 0; b < 2; ++b)
#pragma unroll
            for (int m = 0; m < 4; ++m)
#pragma unroll
                for (int n = 0; n < 2; ++n) acc[a][b][m][n] = (f32x4){0.f, 0.f, 0.f, 0.f};
    bf16x8 At[4][2], B0[2][2], B1[2][2];
    const char* cA = (const char*)g.A + (size_t)cur.pm * tstep; const char* cB = (const char*)g.Bt + (size_t)cur.pn * tstep;
    S.a_ready(cur);
    if constexpr (SP2) {
        PG8_STAGE(PG8_SB(0, 0), cB, voffB); PG8_STAGE(PG8_SB(0, 1), cB + hstep, voffB); PG8_STAGE(PG8_SA(0, 0), cA, voffA); PG8_STAGE(PG8_SA(0, 1), cA + hstep, voffA);
        if (wr == 1) PG8_BAR;
        PG8_WAIT_V(2); PG8_BAR;
        PG8_STAGE(PG8_SB(1, 0), cB + kstep, voffB); PG8_STAGE(PG8_SA(1, 0), cA + kstep, voffA); PG8_STAGE(PG8_SB(1, 1), cB + hstep + kstep, voffB);
        PG8_WAIT_V(6); PG8_BAR;
    } else {
        PG8_STAGE(PG8_SB(0, 0), cB, voffB); PG8_STAGE(PG8_SA(0, 0), cA, voffA); PG8_STAGE(PG8_SB(0, 1), cB + hstep, voffB); PG8_STAGE(PG8_SA(0, 1), cA + hstep, voffA);
        if (wr == 1) PG8_BAR;
        PG8_WAIT_V(4); PG8_BAR;
        PG8_STAGE(PG8_SB(1, 0), cB + kstep, voffB); PG8_STAGE(PG8_SA(1, 0), cA + kstep, voffA); PG8_STAGE(PG8_SB(1, 1), cB + hstep + kstep, voffB);
        PG8_WAIT_V(6); PG8_BAR;
    }
    for (;;) {
        const bool has_next = S.next(ui + 1, nxt);
        const char* nA = has_next ? (const char*)g.A + (size_t)nxt.pm * tstep : cA; const char* nB = has_next ? (const char*)g.Bt + (size_t)nxt.pn * tstep : cB;
        for (int t = 0; t < nt; t += 2) {
            const bool last = (t == nt - 2);
            const char* a1 = cA + (size_t)(t + 1) * kstep;
            const char* a2 = last ? nA : cA + (size_t)(t + 2) * kstep; const char* b2 = last ? nB : cB + (size_t)(t + 2) * kstep;
            const char* a3 = a2 + kstep; const char* b3 = b2 + kstep;
            if (last && has_next) S.a_ready(nxt);
            if constexpr (SP2) {
            PG8_LDB(B0, 0, 0); PG8_LDB(B1, 0, 1); PG8_SCHED; PG8_LDA(At, 0, 0); PG8_STAGE(PG8_SA(1, 1), a1 + hstep, voffA);
            PG8_WAIT_V(8); PG8_WAIT_L(0); PG8_BAR; PG8_MMA(0, 0, At, B0); PG8_MMA(0, 1, At, B1); PG8_BAR; PG8_SCHED;
            PG8_LDA(At, 0, 1); PG8_STAGE(PG8_SB(0, 0), b2, voffB); PG8_STAGE(PG8_SB(0, 1), b2 + hstep, voffB); PG8_STAGE(PG8_SA(0, 0), a2, voffA);
            PG8_WAIT_V(8); PG8_WAIT_L(0); PG8_BAR; PG8_MMA(1, 0, At, B0); PG8_MMA(1, 1, At, B1); PG8_BAR; PG8_SCHED;
            PG8_LDB(B0, 1, 0); PG8_LDB(B1, 1, 1); PG8_SCHED; PG8_LDA(At, 1, 0); PG8_STAGE(PG8_SA(0, 1), a2 + hstep, voffA);
            PG8_WAIT_V(8); PG8_WAIT_L(0); PG8_BAR; PG8_MMA(0, 0, At, B0); PG8_MMA(0, 1, At, B1); PG8_BAR; PG8_SCHED;
            PG8_LDA(At, 1, 1); PG8_STAGE(PG8_SB(1, 0), b3, voffB); PG8_STAGE(PG8_SB(1, 1), b3 + hstep, voffB); PG8_STAGE(PG8_SA(1, 0), a3, voffA);
            PG8_WAIT_V(8); PG8_WAIT_L(0); PG8_BAR; PG8_MMA(1, 0, At, B0); PG8_MMA(1, 1, At, B1); PG8_BAR; PG8_SCHED;
            } else {
            PG8_LDB(B0, 0, 0); PG8_SCHED; PG8_LDA(At, 0, 0); PG8_STAGE(PG8_SA(1, 1), a1 + hstep, voffA);
            PG8_WAIT_L(8); PG8_BAR; PG8_WAIT_L(0); PG8_MMA(0, 0, At, B0); PG8_BAR; PG8_SCHED;
            PG8_LDB(B1, 0, 1); PG8_STAGE(PG8_SB(0, 0), b2, voffB);
            PG8_BAR; PG8_WAIT_L(0); PG8_MMA(0, 1, At, B1); PG8_BAR;
            PG8_LDA(At, 0, 1); PG8_STAGE(PG8_SA(0, 0), a2, voffA);
            PG8_BAR; PG8_WAIT_L(0); PG8_MMA(1, 0, At, B0); PG8_BAR; PG8_SCHED;
            PG8_STAGE(PG8_SB(0, 1), b2 + hstep, voffB);
            PG8_WAIT_V(6); PG8_BAR; PG8_MMA(1, 1, At, B1); PG8_BAR;
            PG8_LDB(B0, 1, 0); PG8_SCHED; PG8_LDA(At, 1, 0); PG8_STAGE(PG8_SA(0, 1), a2 + hstep, voffA);
            PG8_WAIT_L(8); PG8_BAR; PG8_WAIT_L(0); PG8_MMA(0, 0, At, B0); PG8_BAR; PG8_SCHED;
            PG8_LDB(B1, 1, 1); PG8_STAGE(PG8_SB(1, 0), b3, voffB);
            PG8_BAR; PG8_WAIT_L(0); PG8_MMA(0, 1, At, B1); PG8_BAR;
            PG8_LDA(At, 1, 1); PG8_STAGE(PG8_SA(1, 0), a3, voffA);
            PG8_BAR; PG8_WAIT_L(0); PG8_MMA(1, 0, At, B0); PG8_BAR; PG8_SCHED;
            PG8_STAGE(PG8_SB(1, 1), b3 + hstep, voffB);
            PG8_WAIT_V(6); PG8_BAR; PG8_MMA(1, 1, At, B1); PG8_BAR;
            }
        }
        if constexpr (ALIGN_EPI) { if (wr == 0) PG8_BAR; }
        if constexpr (!Epi::AFTER_DRAIN) { E(acc, cur, wr, wc, fr, fq); S.done(cur); }
        if (!has_next) break;
#pragma unroll
        for (int a = 0; a < 2; ++a)
#pragma unroll
            for (int b = 0; b < 2; ++b)
#pragma unroll
                for (int m = 0; m < 4; ++m)
#pragma unroll
                    for (int n = 0; n < 2; ++n) acc[a][b][m][n] = (f32x4){0.f, 0.f, 0.f, 0.f};
        cur = nxt; cA = nA; cB = nB; ++ui;
        if constexpr (ALIGN_EPI) { if (wr == 1) PG8_BAR; }
    }
    PG8_WAIT_V(0);
    if constexpr (!ALIGN_EPI) { if (wr == 0) PG8_BAR; }
    PG8_BAR;
    if constexpr (Epi::AFTER_DRAIN) { E.fused(acc, cur, wr, wc, fr, fq, lds, wid, lane); S.done(cur); }
#undef PG8_SA
#undef PG8_SB
#undef PG8_STAGE
#undef PG8_LDA
#undef PG8_LDB
#undef PG8_MMA
#undef PG8_WAIT_V
#undef PG8_WAIT_L
#undef PG8_BAR
#undef PG8_SCHED
}
}

#ifndef PG8_SP2
#define PG8_SP2 true
#endif
#ifndef PG8_ALIGN
#define PG8_ALIGN true
#endif
#define GAS __attribute__((address_space(1)))
#define LAS __attribute__((address_space(3)))
typedef unsigned short bf16;
typedef unsigned v4u __attribute__((ext_vector_type(4)));
typedef float f32x4 __attribute__((ext_vector_type(4)));
typedef short bf16x8 __attribute__((ext_vector_type(8)));
typedef GAS unsigned gu32;
typedef GAS unsigned long long gu64;
#define RLX_AGENT __ATOMIC_RELAXED, __HIP_MEMORY_SCOPE_AGENT
#define LDS_WAIT() asm volatile("s_waitcnt lgkmcnt(0)" ::: "memory")
#define VM_WAIT() asm volatile("s_waitcnt vmcnt(0)" ::: "memory")
__device__ __forceinline__ unsigned long long rt() { return __builtin_amdgcn_s_memrealtime(); }
__device__ __forceinline__ unsigned f2bf(float f) { unsigned u = __builtin_bit_cast(unsigned, f); return (u + 0x7fffu + ((u >> 16) & 1u)) >> 16; }
__device__ __forceinline__ unsigned pk2(float lo, float hi) { return f2bf(lo) | (f2bf(hi) << 16); }

#define XB_TMO      128
#define XB_XCNT(j)  (256  + 64 * (j))
#define XB_XSUB(j)  (1280 + 64 * (j))
#define XB_XGEN(j)  (2304 + 64 * (j))
#define XB_TOP      3328
#define XB_TOPGEN   3392
#define XCD_BAR_WORDS 3456
#define XB_SPIN_CAP (1u << 18)

__device__ __forceinline__ unsigned xb_ld(unsigned* p)              { return __hip_atomic_load(p, __ATOMIC_RELAXED, __HIP_MEMORY_SCOPE_AGENT); }
__device__ __forceinline__ unsigned xb_add(unsigned* p, unsigned v) { return __hip_atomic_fetch_add(p, v, __ATOMIC_RELAXED, __HIP_MEMORY_SCOPE_AGENT); }
__device__ __forceinline__ unsigned xb_xcc_id() { return (unsigned)__builtin_amdgcn_s_getreg((3 << 11) | 20) & 0xFu; }
#define XB_SPIN(cond, bar) do { unsigned _sp = 0; while (cond) { __builtin_amdgcn_s_sleep(1); \
    if ((++_sp & 255u) == 0u) { if (xb_ld(&(bar)[XB_TMO])) break; if (_sp > XB_SPIN_CAP) { atomicAdd(&(bar)[XB_TMO], 1u); break; } } } } while (0)

struct XcdBarrier {
    unsigned* bar; unsigned x;
    volatile LAS unsigned* st;
};

__device__ __forceinline__ XcdBarrier xcd_barrier_post(unsigned* bar, volatile LAS unsigned* st) {
    XcdBarrier b; b.bar = bar; b.x = xb_xcc_id(); b.st = st;
    if (threadIdx.x == 0) (void)xb_add(&bar[XB_XCNT(b.x)], 1u);
    return b;
}
__device__ __forceinline__ void xcd_barrier_complete(unsigned* bar, unsigned x, unsigned& nloc, unsigned& nx) {
    const unsigned G = gridDim.x * gridDim.y * gridDim.z;
    unsigned sum, cnt, mine, sp = 0u;
    for (;;) {
        sum = 0u; cnt = 0u; mine = 0u;
#pragma unroll
        for (unsigned j = 0; j < 16; ++j) { const unsigned c = xb_ld(&bar[XB_XCNT(j)]); sum += c; cnt += (c > 0u) ? 1u : 0u; mine = (j == x) ? c : mine; }
        if (sum == G) break;
        __builtin_amdgcn_s_sleep(1);
        if ((++sp & 255u) == 0u) { if (xb_ld(&bar[XB_TMO])) break; if (sp > XB_SPIN_CAP) { atomicAdd(&bar[XB_TMO], 1u); break; } }
    }
    nloc = mine > 0u ? mine : 1u; nx = cnt > 0u ? cnt : 1u;
}

__device__ __forceinline__ void xcd_barrier(const XcdBarrier& b) {
    asm volatile("s_waitcnt vmcnt(0)" ::: "memory");
    __syncthreads();
    if (threadIdx.x == 0) {
        unsigned* bar = b.bar;
        __builtin_amdgcn_s_waitcnt(0);
        unsigned nloc = b.st[0], nx = b.st[1];
        if (nloc == 0u) { xcd_barrier_complete(bar, b.x, nloc, nx); b.st[0] = nloc; b.st[1] = nx; }
        const unsigned old = xb_add(&bar[XB_XSUB(b.x)], 1u);
        const unsigned gen = old / nloc;
        if (old + 1u == (gen + 1u) * nloc) {
            __builtin_amdgcn_fence(__ATOMIC_RELEASE, "agent");
            asm volatile("s_waitcnt vmcnt(0)" ::: "memory");
            const unsigned og = xb_add(&bar[XB_TOP], 1u);
            const unsigned tg = og / nx;
            if (og + 1u == (tg + 1u) * nx) xb_add(&bar[XB_TOPGEN], 1u);
            else XB_SPIN(xb_ld(&bar[XB_TOPGEN]) == tg, bar);
            __builtin_amdgcn_fence(__ATOMIC_ACQUIRE, "agent");
            xb_add(&bar[XB_XGEN(b.x)], 1u);
            asm volatile("s_waitcnt vmcnt(0)" ::: "memory");
        } else {
            XB_SPIN(xb_ld(&bar[XB_XGEN(b.x)]) == gen, bar);
            __builtin_amdgcn_fence(__ATOMIC_ACQUIRE, "agent");
            asm volatile("s_waitcnt vmcnt(0)" ::: "memory");
        }
    }
    __syncthreads();
}

constexpr int NWAVES = 8;
constexpr int T_ = 16384, D_ = 1024, INW = 4624, NP = 4864  ;
constexpr int NCH = 256  , MLH = 4, NAH = 8;
constexpr float EPS_ = 1e-6f;
constexpr int C_NAQ = 0, C_NAK = 512, C_NAV = 1024, C_NAZ = 1536, C_MLQ = 2048, C_MLK = 2560, C_MLV = 3072, C_MLO = 3584, C_MLZ = 4096, C_IF = 4608, C_FF = 4612, C_IB = 4616, C_FB = 4620;
#ifndef MK_N_LAUNCHES
#define MK_N_LAUNCHES 1
#endif
constexpr int N_PHASES = 8;
#ifndef NA_FN
#define NA_FN na_fast
#endif
#ifndef MLA_FN
#define MLA_FN mlA_fast
#endif
#ifndef MLO_FN
#define MLO_FN mlO_fast
#endif
constexpr size_t MiB = 1u << 20;
constexpr size_t WS_CTL = 0, CTL_ZERO_BYTES = 64 * 1024;
constexpr size_t WS_MOD = 1 * MiB;
constexpr size_t WS_BIASP = WS_MOD + 16 * 1024;
constexpr size_t WS_BL = WS_MOD + 64 * 1024, WS_MLOC = WS_BL + 8192, WS_MPREV = WS_MLOC + 8192;
constexpr size_t WS_NVEC = 2 * MiB;
constexpr size_t WS_WT1 = 4 * MiB;
constexpr size_t WS_WT2 = 14 * MiB;
constexpr size_t WS_HMIX = 16 * MiB;
constexpr size_t WS_PROJ = 48 * MiB;
constexpr size_t WS_YBUF = 48 * MiB;
constexpr size_t WS_END = 200 * MiB;
constexpr int CW_BAR = 1024;
constexpr int LDS_BYTES = 155648, MISC_OFF = LDS_BYTES - 256;

struct Frame {
    LAS unsigned char* lds;
    volatile LAS unsigned* MISC;
    int tid, lane, wave, G;
    const float *x, *c, *w_ada, *b_ada, *norm_w, *w_in, *b_in, *conv_w, *conv_b, *rpb, *ml_norm_w, *w_out, *final_norm_w;
    float* out;
    float *mod, *biasp, *BL, *MLOC, *MPREV, *NVEC, *ybuf;
    bf16 *WT1, *WT2, *HMIX, *PROJ, *UC;
};

__device__ __forceinline__ float bf2f(unsigned short u) { return __uint_as_float(((unsigned)u) << 16); }
__device__ __forceinline__ float wave_sum(float v) {
#pragma unroll
    for (int o = 1; o < 64; o <<= 1) v += __shfl_xor(v, o);
    return v;
}
__device__ __forceinline__ float wave_max(float v) {
#pragma unroll
    for (int o = 1; o < 64; o <<= 1) v = fmaxf(v, __shfl_xor(v, o));
    return v;
}
__device__ __forceinline__ float rdlane(float v, int l) { return __int_as_float(__builtin_amdgcn_readlane(__float_as_int(v), l)); }
__device__ __forceinline__ float scan_sum(float v, int lane, int dir) {
#pragma unroll
    for (int o = 1; o < 64; o <<= 1) { const float up = __shfl_up(v, o), dn = __shfl_down(v, o); if (dir == 0) { if (lane >= o) v += up; } else { if (lane + o < 64) v += dn; } }
    return v;
}
__device__ __forceinline__ float scan_max(float v, int lane, int dir) {
#pragma unroll
    for (int o = 1; o < 64; o <<= 1) { const float up = __shfl_up(v, o), dn = __shfl_down(v, o); if (dir == 0) { if (lane >= o) v = fmaxf(v, up); } else { if (lane + o < 64) v = fmaxf(v, dn); } }
    return v;
}
__device__ __forceinline__ float logsigmoidf(float f) { return fminf(f, 0.f) - log1pf(expf(-fabsf(f))); }
__device__ __forceinline__ float siluf(float v) { return v / (1.f + expf(-v)); }
__host__ __device__ __forceinline__ int blob_idx(int e, int d) { const int et = e >> 4, ks = d >> 5, dd = d & 31, g = (dd & 15) >> 2, j = (dd & 3) + ((dd >> 4) << 2); return ((et * 4 + ks) * 64 + (e & 15) + 16 * g) * 8 + j; }

__device__ __forceinline__ void p0_mod(Frame& F) {
    LAS float* red = (LAS float*)F.lds;
    const int tid = F.tid;
    for (int blk = blockIdx.x; blk < 192; blk += F.G) {
        const int col = tid & 15, rg = tid >> 4, j = blk * 16 + col;
        float s = 0.f;
        for (int it = 0; it < 32; ++it) { const int i = rg + 32 * it; const float cv = F.c[i]; s += siluf(cv) * F.w_ada[(size_t)i * 3072 + j]; }
        red[rg * 16 + col] = s;
        __syncthreads();
        if (tid < 16) { float t = F.b_ada[blk * 16 + tid]; for (int r = 0; r < 32; ++r) t += red[r * 16 + tid]; F.mod[blk * 16 + tid] = t; }
        __syncthreads();
    }
    const int gt = blockIdx.x * (NWAVES * 64) + tid, NGT = F.G * NWAVES * 64;
    v4u* z = (v4u*)(F.WT1 + (size_t)INW * D_);
    for (int i = gt; i < (NP - INW) * D_ * 2 / 16; i += NGT) z[i] = (v4u){0u, 0u, 0u, 0u};
    for (int i = gt; i < NP; i += NGT) F.biasp[i] = i < INW ? F.b_in[i] : 0.f;
}

__device__ __forceinline__ void transpose_item(const float* W, int K, int N, bf16* WT, LAS float* scr, int item, int lane) {
    const int nblk = (N + 31) / 32, kb = item / nblk, nb = item % nblk, k0 = 64 * kb, n0 = 32 * nb;
#pragma unroll 8
    for (int i = 0; i < 32; ++i) { const int kk = 2 * i + (lane >> 5), n = n0 + (lane & 31); scr[kk * 33 + (lane & 31)] = n < N ? W[(size_t)(k0 + kk) * N + n] : 0.f; }
    LDS_WAIT(); asm volatile("" ::: "memory");
    const int c = lane & 7;
#pragma unroll
    for (int j = 0; j < 4; ++j) { const int n = (lane >> 3) + 8 * j; const LAS float* s = scr + (8 * c) * 33 + n;
        v4u o; o.x = pk2(s[0 * 33], s[1 * 33]); o.y = pk2(s[2 * 33], s[3 * 33]); o.z = pk2(s[4 * 33], s[5 * 33]); o.w = pk2(s[6 * 33], s[7 * 33]);
        *(GAS v4u*)(WT + (size_t)(n0 + n) * K + k0 + 8 * c) = o; }
    LDS_WAIT(); asm volatile("" ::: "memory");
}
__device__ __forceinline__ void p1_prep(Frame& F) {
    LAS float* scr = (LAS float*)(F.lds + F.wave * 16384);
    const int gw = blockIdx.x * NWAVES + F.wave, NGW = F.G * NWAVES;
    constexpr int I_1 = (D_ / 64) * ((INW + 31) / 32), I_2 = (D_ / 64) * (D_ / 32);
    for (int it = gw; it < I_1 + I_2; it += NGW) {
        if (it < I_1) transpose_item(F.w_in, D_, INW, F.WT1, scr, it, F.lane);
        else transpose_item(F.w_out, D_, D_, F.WT2, scr, it - I_1, F.lane);
    }
    f32x4 sc[4], sh[4];
#pragma unroll
    for (int j = 0; j < 4; ++j) { const int k = 4 * F.lane + 256 * j; const f32x4 nw = *(const f32x4*)(F.norm_w + k), scl = *(const f32x4*)(F.mod + 1024 + k); sh[j] = *(const f32x4*)(F.mod + k); sc[j] = nw * (scl + 1.0f); }
    for (int m = gw; m < T_; m += NGW) {
        const GAS f32x4* xr = (const GAS f32x4*)(F.x + (size_t)m * D_) + F.lane;
        f32x4 v[4]; float s = 0.f;
#pragma unroll
        for (int j = 0; j < 4; ++j) { v[j] = xr[64 * j]; s += (v[j].x * v[j].x + v[j].y * v[j].y) + (v[j].z * v[j].z + v[j].w * v[j].w); }
        const float rstd = 1.f / sqrtf(wave_sum(s) * (1.f / D_) + EPS_);
        GAS unsigned long long* o8 = (GAS unsigned long long*)(F.HMIX + (size_t)m * D_) + F.lane;
#pragma unroll
        for (int j = 0; j < 4; ++j) { const f32x4 h = v[j] * rstd * sc[j] + sh[j]; o8[64 * j] = (unsigned long long)pk2(h.x, h.y) | ((unsigned long long)pk2(h.z, h.w) << 32); }
    }
}

__device__ __forceinline__ void na_slow(Frame& F) {
    const int gw = blockIdx.x * NWAVES + F.wave, NGW = F.G * NWAVES, lane = F.lane;
    for (int task = gw; task < T_ * NAH; task += NGW) {
        const int c = task & 63, hh = (task >> 6) & 7, r = task >> 9, t = r * 64 + c;
        const int rs = min(max(r - 4, 0), NCH - 8), cs = min(max(c - 8, 0), 48);
        const bf16* prow = F.PROJ + (size_t)t * NP;
        const float qv = bf2f(prow[C_NAQ + hh * 64 + lane]) * 0.125f;
        const int j0 = lane >> 4, xo = lane & 15;
        const int tok0 = (rs + j0) * 64 + cs + xo, tok1 = tok0 + 4 * 64;
        const v4u* k0p = (const v4u*)(F.PROJ + (size_t)tok0 * NP + C_NAK + hh * 64);
        const v4u* k1p = (const v4u*)(F.PROJ + (size_t)tok1 * NP + C_NAK + hh * 64);
        float s0 = 0.f, s1 = 0.f;
#pragma unroll
        for (int ch = 0; ch < 8; ++ch) {
            const v4u a = k0p[ch], b = k1p[ch];
#pragma unroll
            for (int e = 0; e < 4; ++e) {
                const float q0 = rdlane(qv, ch * 8 + 2 * e), q1 = rdlane(qv, ch * 8 + 2 * e + 1);
                s0 += q0 * __uint_as_float(a[e] << 16) + q1 * __uint_as_float(a[e] & 0xffff0000u);
                s1 += q0 * __uint_as_float(b[e] << 16) + q1 * __uint_as_float(b[e] & 0xffff0000u);
            }
        }
        const int dx = cs + xo - c + 15;
        s0 += F.rpb[(hh * 15 + (rs + j0 - r + 7)) * 31 + dx];
        s1 += F.rpb[(hh * 15 + (rs + j0 + 4 - r + 7)) * 31 + dx];
        const float m = wave_max(fmaxf(s0, s1));
        float p0 = expf(s0 - m), p1 = expf(s1 - m);
        const float inv = 1.f / wave_sum(p0 + p1);
        p0 *= inv; p1 *= inv;
        float o = 0.f;
        const bf16* vb = F.PROJ + C_NAV + hh * 64 + lane;
#pragma unroll
        for (int kk = 0; kk < 64; ++kk) {
            const int tk = (rs + (kk >> 4)) * 64 + cs + (kk & 15);
            o += rdlane(p0, kk) * bf2f(vb[(size_t)tk * NP]) + rdlane(p1, kk) * bf2f(vb[(size_t)(tk + 256) * NP]);
        }
        const float z = bf2f(prow[C_NAZ + hh * 64 + lane]);
        F.HMIX[(size_t)t * D_ + hh * 64 + lane] = (bf16)f2bf(o * siluf(z));
    }
}

__device__ __forceinline__ float conv_silu(const Frame& F, int tok, int ch) {
    float acc = F.conv_b[ch];
#pragma unroll
    for (int j = 0; j < 5; ++j) { const int tt = tok + j - 2; if (tt >= 0 && tt < T_) acc += bf2f(F.PROJ[(size_t)tt * NP + C_MLQ + ch]) * F.conv_w[j * 1024 + ch]; }
    return siluf(acc);
}

__device__ __forceinline__ void mlA_slow(Frame& F) {
    LAS float* kc = (LAS float*)F.lds;
    LAS float* vv = kc + 64 * 128;
    LAS float* wt = vv + 64 * 128;
    const int tid = F.tid, lane = F.lane;
    for (int unit = blockIdx.x; unit < NCH * MLH; unit += F.G) {
        const int chunk = unit >> 2, hh = unit & 3, tok0 = chunk * 64;
        if (F.wave < 2) {
            const int dir = F.wave, ub = unit * 2 + dir;
            const bf16* pr = F.PROJ + (size_t)(tok0 + lane) * NP;
            const float f = bf2f(pr[(dir ? C_FB : C_FF) + hh]), ig = bf2f(pr[(dir ? C_IB : C_IF) + hh]);
            const float b = scan_sum(logsigmoidf(f), lane, dir);
            const float bl = rdlane(b, dir ? 0 : 63);
            const float a = bl - b + ig;
            const float mloc = wave_max(a);
            wt[dir * 64 + lane] = expf(a - mloc);
            if (lane == 0) { F.BL[ub] = bl; F.MLOC[ub] = mloc; }
        }
        for (int idx = tid; idx < 64 * 128; idx += NWAVES * 64) {
            const int s = idx >> 7, d = idx & 127;
            kc[idx] = conv_silu(F, tok0 + s, 512 + hh * 128 + d) * 0.08838834764831845f;
            vv[idx] = bf2f(F.PROJ[(size_t)(tok0 + s) * NP + C_MLV + hh * 128 + d]);
        }
        __syncthreads();
        const int d = tid & 127, eg = tid >> 7;
#pragma unroll 1
        for (int dir = 0; dir < 2; ++dir) {
            const int ub = unit * 2 + dir;
            float acc[32];
#pragma unroll
            for (int i = 0; i < 32; ++i) acc[i] = 0.f;
#pragma unroll 2
            for (int s = 0; s < 64; ++s) {
                const float kd = kc[s * 128 + d] * wt[dir * 64 + s];
#pragma unroll
                for (int i = 0; i < 32; ++i) acc[i] += kd * vv[s * 128 + eg * 32 + i];
            }
            bf16* ub_p = F.UC + (size_t)ub * 16384;
#pragma unroll
            for (int i = 0; i < 32; ++i) ub_p[blob_idx(eg * 32 + i, d)] = (bf16)f2bf(acc[i]);
        }
        if (tid < 256) { const int dir = tid >> 7, dd = tid & 127; float n = 0.f; for (int s = 0; s < 64; ++s) n += wt[dir * 64 + s] * kc[s * 128 + dd]; F.NVEC[(size_t)(unit * 2 + dir) * 128 + dd] = n; }
        __syncthreads();
    }
}

__device__ __forceinline__ void ml_scan(Frame& F) {
    LAS float* dec = (LAS float*)F.lds;
    LAS float* scl = dec + 256;
    LAS float* tb = scl + 256;
    const int tid = F.tid;
    for (int w = blockIdx.x; w < 256; w += F.G) {
        const int stream = w & 7, slice = w >> 3, hh = stream >> 1, dir = stream & 1;
        if (tid < 256) { const int chunk = dir ? 255 - tid : tid, ub = (chunk * 4 + hh) * 2 + dir; tb[tid] = F.BL[ub]; tb[256 + tid] = F.MLOC[ub]; }
        __syncthreads();
        if (tid == 0) {
            float m = 0.f;
            for (int st = 0; st < 256; ++st) {
                const int chunk = dir ? 255 - st : st, ub = (chunk * 4 + hh) * 2 + dir;
                const float bl = tb[st], ml = tb[256 + st], mn = fmaxf(bl + m, ml);
                dec[st] = expf(bl + m - mn); scl[st] = expf(ml - mn);
                if (slice == 0) F.MPREV[ub] = m;
                m = mn;
            }
        }
        __syncthreads();
        {
            const int elem = slice * 512 + tid;
            float C = 0.f;
            bf16* base = F.UC + elem;
            for (int st0 = 0; st0 < 256; st0 += 16) {
                float u[16];
#pragma unroll
                for (int k = 0; k < 16; ++k) { const int st = st0 + k, chunk = dir ? 255 - st : st, ub = (chunk * 4 + hh) * 2 + dir; u[k] = bf2f(base[(size_t)ub * 16384]); }
#pragma unroll
                for (int k = 0; k < 16; ++k) { const int st = st0 + k, chunk = dir ? 255 - st : st, ub = (chunk * 4 + hh) * 2 + dir; base[(size_t)ub * 16384] = (bf16)f2bf(C); C = dec[st] * C + scl[st] * u[k]; }
            }
        }
        if (slice == 1 && tid < 128) {
            float n = 0.f;
            for (int st = 0; st < 256; ++st) { const int chunk = dir ? 255 - st : st, ub = (chunk * 4 + hh) * 2 + dir; float* p = F.NVEC + (size_t)ub * 128 + tid; const float u = *p; *p = n; n = dec[st] * n + scl[st] * u; }
        }
        __syncthreads();
    }
}

__device__ __forceinline__ void mlO_slow(Frame& F) {
    constexpr int LD = 129;
    LAS float* qc = (LAS float*)F.lds;
    LAS float* kc = qc + 64 * LD;
    LAS float* vv = kc + 64 * LD;
    LAS float* S = vv + 64 * 128;
    LAS float* ga = S + 64 * 65;
    const int tid = F.tid, lane = F.lane;
    for (int unit = blockIdx.x; unit < NCH * MLH; unit += F.G) {
        const int chunk = unit >> 2, hh = unit & 3, tok0 = chunk * 64;
        if (F.wave < 2) {
            const int dir = F.wave, ub = unit * 2 + dir;
            const bf16* pr = F.PROJ + (size_t)(tok0 + lane) * NP;
            const float f = bf2f(pr[(dir ? C_FB : C_FF) + hh]), ig = bf2f(pr[(dir ? C_IB : C_IF) + hh]);
            const float b = scan_sum(logsigmoidf(f), lane, dir);
            const float u = ig - b;
            const float pm = scan_max(u, lane, dir);
            const float mp = F.MPREV[ub];
            const float M = fmaxf(mp, pm);
            LAS float* g = ga + dir * 320;
            g[lane] = u; g[64 + lane] = M; g[128 + lane] = expf(mp - M); g[192 + lane] = expf(-(b + M));
        }
        for (int idx = tid; idx < 64 * 128; idx += NWAVES * 64) {
            const int s = idx >> 7, d = idx & 127;
            qc[s * LD + d] = conv_silu(F, tok0 + s, hh * 128 + d);
            kc[s * LD + d] = conv_silu(F, tok0 + s, 512 + hh * 128 + d) * 0.08838834764831845f;
            vv[idx] = bf2f(F.PROJ[(size_t)(tok0 + s) * NP + C_MLV + hh * 128 + d]);
        }
        __syncthreads();
        float hsum[16];
#pragma unroll
        for (int i = 0; i < 16; ++i) hsum[i] = 0.f;
#pragma unroll 1
        for (int dir = 0; dir < 2; ++dir) {
            const int ub = unit * 2 + dir;
            LAS float* g = ga + dir * 320;
            {
                const int s = tid & 63, tg = tid >> 6;
                float acc[8];
#pragma unroll
                for (int j = 0; j < 8; ++j) acc[j] = 0.f;
                for (int d = 0; d < 128; ++d) { const float kv = kc[s * LD + d];
#pragma unroll
                    for (int j = 0; j < 8; ++j) acc[j] += kv * qc[(tg * 8 + j) * LD + d]; }
                const float us = g[s];
#pragma unroll
                for (int j = 0; j < 8; ++j) { const int t = tg * 8 + j; const bool ok = dir ? (s >= t) : (s <= t); S[t * 65 + s] = ok ? acc[j] * expf(fminf(us - g[64 + t], 0.f)) : 0.f; }
            }
            __syncthreads();
            if (tid < 64) {
                const int t = tid; float rs = 0.f, nq = 0.f;
                for (int s = 0; s < 64; ++s) rs += S[t * 65 + s];
                for (int d = 0; d < 128; ++d) nq += F.NVEC[(size_t)ub * 128 + d] * qc[t * LD + d];
                const float den = rs + g[128 + t] * nq;
                g[256 + t] = 1.f / fmaxf(fabsf(den), g[192 + t]);
            }
            {
                const int e = tid & 127, tg = tid >> 7;
                float acc[16];
#pragma unroll
                for (int i = 0; i < 16; ++i) acc[i] = 0.f;
                const v4u* cb = (const v4u*)(F.UC + (size_t)ub * 16384);
#pragma unroll
                for (int ks = 0; ks < 4; ++ks)
#pragma unroll
                    for (int gq = 0; gq < 4; ++gq) {
                        const v4u cv = cb[((e >> 4) * 4 + ks) * 64 + (e & 15) + 16 * gq];
#pragma unroll
                        for (int j = 0; j < 8; ++j) {
                            const int d = 32 * ks + (j < 4 ? 4 * gq + j : 16 + 4 * gq + (j - 4));
                            const unsigned wv = cv[j >> 1];
                            const float cval = (j & 1) ? __uint_as_float(wv & 0xffff0000u) : __uint_as_float(wv << 16);
#pragma unroll
                            for (int i = 0; i < 16; ++i) acc[i] += cval * qc[(tg * 16 + i) * LD + d];
                        }
                    }
#pragma unroll
                for (int i = 0; i < 16; ++i) acc[i] *= g[128 + tg * 16 + i];
                for (int s = 0; s < 64; ++s) { const float ve = vv[s * 128 + e];
#pragma unroll
                    for (int i = 0; i < 16; ++i) acc[i] += S[(tg * 16 + i) * 65 + s] * ve; }
                __syncthreads();
#pragma unroll
                for (int i = 0; i < 16; ++i) hsum[i] += acc[i] * g[256 + tg * 16 + i];
            }
            __syncthreads();
        }
        {
            const int e = tid & 127, tg = tid >> 7;
#pragma unroll
            for (int i = 0; i < 16; ++i) { const int t = tg * 16 + i; const float o = bf2f(F.PROJ[(size_t)(tok0 + t) * NP + C_MLO + hh * 128 + e]); qc[t * 128 + e] = hsum[i] / (1.f + expf(-o)); }
            __syncthreads();
#pragma unroll 1
            for (int r = 0; r < 8; ++r) {
                const int t = F.wave * 8 + r;
                const float a = qc[t * 128 + lane], b = qc[t * 128 + 64 + lane];
                const float mu = wave_sum(a + b) * (1.f / 128.f);
                const float da = a - mu, db = b - mu;
                const float rstd = 1.f / sqrtf(wave_sum(da * da + db * db) * (1.f / 128.f) + EPS_);
                const bf16* pz = F.PROJ + (size_t)(tok0 + t) * NP + C_MLZ + hh * 128;
                bf16* po = F.HMIX + (size_t)(tok0 + t) * D_ + 512 + hh * 128;
                po[lane] = (bf16)f2bf(da * rstd * F.ml_norm_w[hh * 128 + lane] * siluf(bf2f(pz[lane])));
                po[64 + lane] = (bf16)f2bf(db * rstd * F.ml_norm_w[hh * 128 + 64 + lane] * siluf(bf2f(pz[64 + lane])));
            }
        }
        __syncthreads();
    }
}


typedef short s16x4_t __attribute__((ext_vector_type(4)));
typedef unsigned long long u64_t;
#define MFMA16(a, b, c) __builtin_amdgcn_mfma_f32_16x16x32_bf16((a), (b), (c), 0, 0, 0)
__device__ __forceinline__ s16x4_t lds_tr4(const LAS unsigned char* p) { return __builtin_bit_cast(s16x4_t, __builtin_amdgcn_ds_read_tr16_b64_v4i16((LAS s16x4_t*)p)); }
__device__ __forceinline__ bf16x8 tr_frag(const LAS unsigned char* tile, int pitch, int row0, int col0, int lane) {
    const int i = lane & 15, g = lane >> 4;
    const LAS unsigned char* p = tile + (row0 + 4 * g + (i >> 2)) * pitch + (col0 + 4 * (i & 3)) * 2;
    const s16x4_t lo = lds_tr4(p), hi = lds_tr4(p + 16 * pitch);
    return (bf16x8){lo[0], lo[1], lo[2], lo[3], hi[0], hi[1], hi[2], hi[3]};
}
__device__ __forceinline__ unsigned pk2f(float lo, float hi) { return pk2(lo, hi); }
__device__ __forceinline__ float bflo(unsigned w) { return __uint_as_float(w << 16); }
__device__ __forceinline__ float bfhi(unsigned w) { return __uint_as_float(w & 0xffff0000u); }

constexpr int QK_P = 272, V_P = 288;
__device__ __forceinline__ void conv8(const Frame& F, int tok, int ch0, float (&o)[8]) {
    const f32x4 b0 = *(const f32x4*)(F.conv_b + ch0), b1 = *(const f32x4*)(F.conv_b + ch0 + 4);
    float a[8] = {b0.x, b0.y, b0.z, b0.w, b1.x, b1.y, b1.z, b1.w};
#pragma unroll
    for (int j = 0; j < 5; ++j) {
        const int tt = tok + j - 2; const bool ok = (tt >= 0) && (tt < T_); const int tc = ok ? tt : tok;
        v4u xv = *(const v4u*)(F.PROJ + (size_t)tc * NP + C_MLQ + ch0);
        if (!ok) xv = (v4u){0u, 0u, 0u, 0u};
        const f32x4 w0 = *(const f32x4*)(F.conv_w + j * 1024 + ch0), w1 = *(const f32x4*)(F.conv_w + j * 1024 + ch0 + 4);
        a[0] += bflo(xv.x) * w0.x; a[1] += bfhi(xv.x) * w0.y; a[2] += bflo(xv.y) * w0.z; a[3] += bfhi(xv.y) * w0.w;
        a[4] += bflo(xv.z) * w1.x; a[5] += bfhi(xv.z) * w1.y; a[6] += bflo(xv.w) * w1.z; a[7] += bfhi(xv.w) * w1.w;
    }
#pragma unroll
    for (int e = 0; e < 8; ++e) o[e] = a[e] / (1.f + __expf(-a[e]));
}

__device__ __forceinline__ void mlA_fast(Frame& F) {
    LAS unsigned char* KWF = F.lds;
    LAS unsigned char* KWB = KWF + 64 * V_P;
    LAS unsigned char* VV = KWB + 64 * V_P;
    LAS float* wt = (LAS float*)(VV + 64 * V_P);
    const int tid = F.tid, lane = F.lane, l15 = lane & 15, g = lane >> 4;
    for (int unit = blockIdx.x; unit < NCH * MLH; unit += F.G) {
        const int chunk = unit >> 2, hh = unit & 3, tok0 = chunk * 64;
        if (F.wave == 0 || F.wave == 4) {
            const int dir = F.wave >> 2, ub = unit * 2 + dir;
            const bf16* pr = F.PROJ + (size_t)(tok0 + lane) * NP;
            const float f = bf2f(pr[(dir ? C_FB : C_FF) + hh]), ig = bf2f(pr[(dir ? C_IB : C_IF) + hh]);
            const float b = scan_sum(logsigmoidf(f), lane, dir);
            const float bl = rdlane(b, dir ? 0 : 63);
            const float a = bl - b + ig;
            const float mloc = wave_max(a);
            wt[dir * 64 + lane] = __expf(a - mloc);
            if (lane == 0) { F.BL[ub] = bl; F.MLOC[ub] = mloc; }
        }
        __syncthreads();
#pragma unroll
        for (int k = 0; k < 2; ++k) {
            const int idx = tid + 512 * k, s = idx >> 4, cg = idx & 15;
            float kc[8]; conv8(F, tok0 + s, 512 + hh * 128 + cg * 8, kc);
            const float wf = wt[s] * 0.08838834764831845f, wb = wt[64 + s] * 0.08838834764831845f;
            v4u o;
            o.x = pk2(kc[0] * wf, kc[1] * wf); o.y = pk2(kc[2] * wf, kc[3] * wf); o.z = pk2(kc[4] * wf, kc[5] * wf); o.w = pk2(kc[6] * wf, kc[7] * wf);
            *(LAS v4u*)(KWF + s * V_P + cg * 16) = o;
            o.x = pk2(kc[0] * wb, kc[1] * wb); o.y = pk2(kc[2] * wb, kc[3] * wb); o.z = pk2(kc[4] * wb, kc[5] * wb); o.w = pk2(kc[6] * wb, kc[7] * wb);
            *(LAS v4u*)(KWB + s * V_P + cg * 16) = o;
            *(LAS v4u*)(VV + s * V_P + cg * 16) = *(const v4u*)(F.PROJ + (size_t)(tok0 + s) * NP + C_MLV + hh * 128 + cg * 8);
        }
        __syncthreads();
        {
            const int dir = F.wave >> 2, wq = F.wave & 3, ub = unit * 2 + dir;
            const LAS unsigned char* KW = dir ? KWB : KWF;
            f32x4 acc[2][8];
#pragma unroll
            for (int ep = 0; ep < 2; ++ep)
#pragma unroll
                for (int dt = 0; dt < 8; ++dt) acc[ep][dt] = (f32x4){0.f, 0.f, 0.f, 0.f};
#pragma unroll
            for (int kk = 0; kk < 2; ++kk) {
                const bf16x8 b0 = tr_frag(VV, V_P, 32 * kk, 16 * (2 * wq), lane), b1 = tr_frag(VV, V_P, 32 * kk, 16 * (2 * wq + 1), lane);
#pragma unroll
                for (int dt = 0; dt < 8; ++dt) { const bf16x8 a = tr_frag(KW, V_P, 32 * kk, 16 * dt, lane); acc[0][dt] = MFMA16(a, b0, acc[0][dt]); acc[1][dt] = MFMA16(a, b1, acc[1][dt]); }
            }
            v4u* blob = (v4u*)(F.UC + (size_t)ub * 16384);
#pragma unroll
            for (int ep = 0; ep < 2; ++ep)
#pragma unroll
                for (int ks = 0; ks < 4; ++ks) { const f32x4 x0 = acc[ep][2 * ks], x1 = acc[ep][2 * ks + 1]; v4u w; w.x = pk2(x0.x, x0.y); w.y = pk2(x0.z, x0.w); w.z = pk2(x1.x, x1.y); w.w = pk2(x1.z, x1.w);
                    blob[((2 * wq + ep) * 4 + ks) * 64 + lane] = w; }
        }
        if (tid < 256) { const int dir = tid >> 7, dd = tid & 127; const LAS unsigned short* kw = (const LAS unsigned short*)(dir ? KWB : KWF); float n = 0.f;
#pragma unroll 8
            for (int s = 0; s < 64; ++s) n += bf2f(kw[s * (V_P / 2) + dd]); F.NVEC[(size_t)(unit * 2 + dir) * 128 + dd] = n; }
        __syncthreads();
    }
}

__device__ __forceinline__ void mlO_fast(Frame& F) {
    LAS unsigned char* QC = F.lds;
    LAS unsigned char* KC = QC + 64 * QK_P;
    LAS unsigned char* VV = KC + 64 * QK_P;
    LAS unsigned short* OO = (LAS unsigned short*)(VV + 64 * V_P);
    LAS unsigned short* ZZ = OO + 64 * 128;
    LAS float* ga = (LAS float*)(ZZ + 64 * 128);
    LAS f32x4* XH = (LAS f32x4*)(ga + 2 * 320);
    const int tid = F.tid, lane = F.lane, l15 = lane & 15, g = lane >> 4;
    for (int unit = blockIdx.x; unit < NCH * MLH; unit += F.G) {
        const int chunk = unit >> 2, hh = unit & 3, tok0 = chunk * 64;
        if (F.wave == 0 || F.wave == 4) {
            const int dir = F.wave >> 2, ub = unit * 2 + dir;
            const bf16* pr = F.PROJ + (size_t)(tok0 + lane) * NP;
            const float f = bf2f(pr[(dir ? C_FB : C_FF) + hh]), ig = bf2f(pr[(dir ? C_IB : C_IF) + hh]);
            const float b = scan_sum(logsigmoidf(f), lane, dir);
            const float u = ig - b;
            const float pm = scan_max(u, lane, dir);
            const float mp = F.MPREV[ub];
            const float M = fmaxf(mp, pm);
            LAS float* gq = ga + dir * 320;
            gq[lane] = u; gq[64 + lane] = M; gq[128 + lane] = __expf(mp - M); gq[192 + lane] = __expf(-(b + M));
        }
#pragma unroll
        for (int k = 0; k < 2; ++k) {
            const int idx = tid + 512 * k, s = idx >> 4, cg = idx & 15;
            float c8[8]; v4u o;
            conv8(F, tok0 + s, hh * 128 + cg * 8, c8);
            o.x = pk2(c8[0], c8[1]); o.y = pk2(c8[2], c8[3]); o.z = pk2(c8[4], c8[5]); o.w = pk2(c8[6], c8[7]);
            *(LAS v4u*)(QC + s * QK_P + cg * 16) = o;
            conv8(F, tok0 + s, 512 + hh * 128 + cg * 8, c8);
            const float ksc = 0.08838834764831845f;
            o.x = pk2(c8[0] * ksc, c8[1] * ksc); o.y = pk2(c8[2] * ksc, c8[3] * ksc); o.z = pk2(c8[4] * ksc, c8[5] * ksc); o.w = pk2(c8[6] * ksc, c8[7] * ksc);
            *(LAS v4u*)(KC + s * QK_P + cg * 16) = o;
            const bf16* pr = F.PROJ + (size_t)(tok0 + s) * NP + hh * 128 + cg * 8;
            *(LAS v4u*)(VV + s * V_P + cg * 16) = *(const v4u*)(pr + C_MLV);
            *(LAS v4u*)((LAS unsigned char*)OO + s * 256 + cg * 16) = *(const v4u*)(pr + C_MLO);
            *(LAS v4u*)((LAS unsigned char*)ZZ + s * 256 + cg * 16) = *(const v4u*)(pr + C_MLZ);
        }
        __syncthreads();
        const int dir = F.wave >> 2, wq = F.wave & 3, ub = unit * 2 + dir;
        LAS float* gq = ga + dir * 320;
        f32x4 o[8];
        {
            const int t = 16 * wq + l15;
            bf16x8 qn[4];
#pragma unroll
            for (int ks = 0; ks < 4; ++ks) qn[ks] = *(const LAS bf16x8*)(QC + t * QK_P + (32 * ks + 8 * g) * 2);
            f32x4 gacc[4];
#pragma unroll
            for (int st = 0; st < 4; ++st) { gacc[st] = (f32x4){0.f, 0.f, 0.f, 0.f};
#pragma unroll
                for (int ks = 0; ks < 4; ++ks) { const bf16x8 a = *(const LAS bf16x8*)(KC + (16 * st + l15) * QK_P + (32 * ks + 8 * g) * 2); gacc[st] = MFMA16(a, qn[ks], gacc[st]); } }
            const float Mt = gq[64 + t];
            float rs = 0.f;
#pragma unroll
            for (int st = 0; st < 4; ++st) { const f32x4 us = *(const LAS f32x4*)(gq + 16 * st + 4 * g);
#pragma unroll
                for (int r = 0; r < 4; ++r) { const int s = 16 * st + 4 * g + r; const bool ok = dir ? (s >= t) : (s <= t); const float p = ok ? gacc[st][r] * __expf(fminf(us[r] - Mt, 0.f)) : 0.f; gacc[st][r] = p; rs += p; } }
            rs += __shfl_xor(rs, 16); rs += __shfl_xor(rs, 32);
            float nq = 0.f;
            const float* np = F.NVEC + (size_t)ub * 128;
#pragma unroll
            for (int ks = 0; ks < 4; ++ks) { const f32x4 n0 = *(const f32x4*)(np + 32 * ks + 8 * g), n1 = *(const f32x4*)(np + 32 * ks + 8 * g + 4); const bf16x8 q = qn[ks];
                nq += bf2f((unsigned short)q[0]) * n0.x + bf2f((unsigned short)q[1]) * n0.y + bf2f((unsigned short)q[2]) * n0.z + bf2f((unsigned short)q[3]) * n0.w
                    + bf2f((unsigned short)q[4]) * n1.x + bf2f((unsigned short)q[5]) * n1.y + bf2f((unsigned short)q[6]) * n1.z + bf2f((unsigned short)q[7]) * n1.w; }
            nq += __shfl_xor(nq, 16); nq += __shfl_xor(nq, 32);
            const float den = rs + gq[128 + t] * nq;
            if (g == 0) gq[256 + t] = 1.f / fmaxf(fabsf(den), gq[192 + t]);
            bf16x8 pa[2];
#pragma unroll
            for (int kk = 0; kk < 2; ++kk) { const f32x4 x0 = gacc[2 * kk], x1 = gacc[2 * kk + 1]; const v4u w = (v4u){pk2(x0.x, x0.y), pk2(x0.z, x0.w), pk2(x1.x, x1.y), pk2(x1.z, x1.w)}; pa[kk] = __builtin_bit_cast(bf16x8, w); }
#pragma unroll
            for (int et = 0; et < 8; ++et) o[et] = (f32x4){0.f, 0.f, 0.f, 0.f};
            const v4u* blob = (const v4u*)(F.UC + (size_t)ub * 16384);
#pragma unroll
            for (int ks = 0; ks < 4; ++ks) {
                const u64_t qlo = *(const LAS u64_t*)(QC + t * QK_P + (32 * ks + 4 * g) * 2), qhi = *(const LAS u64_t*)(QC + t * QK_P + (32 * ks + 16 + 4 * g) * 2);
                const v4u qw = (v4u){(unsigned)qlo, (unsigned)(qlo >> 32), (unsigned)qhi, (unsigned)(qhi >> 32)};
                const bf16x8 qp = __builtin_bit_cast(bf16x8, qw);
#pragma unroll
                for (int et = 0; et < 8; ++et) { const v4u cw = blob[(et * 4 + ks) * 64 + lane]; o[et] = MFMA16(qp, __builtin_bit_cast(bf16x8, cw), o[et]); }
            }
            const f32x4 it4 = *(const LAS f32x4*)(gq + 128 + 16 * wq + 4 * g);
#pragma unroll
            for (int et = 0; et < 8; ++et) o[et] = o[et] * it4;
#pragma unroll
            for (int kk = 0; kk < 2; ++kk)
#pragma unroll
                for (int et = 0; et < 8; ++et) { const bf16x8 b = tr_frag(VV, V_P, 32 * kk, 16 * et, lane); o[et] = MFMA16(pa[kk], b, o[et]); }
            const f32x4 rd4 = *(const LAS f32x4*)(gq + 256 + 16 * wq + 4 * g);
#pragma unroll
            for (int et = 0; et < 8; ++et) o[et] = o[et] * rd4;
        }
        if (dir == 1) {
#pragma unroll
            for (int et = 0; et < 8; ++et) XH[(wq * 8 + et) * 64 + lane] = o[et];
        }
        __syncthreads();
        if (dir == 0) {
#pragma unroll
            for (int et = 0; et < 8; ++et) o[et] = o[et] + XH[(wq * 8 + et) * 64 + lane];
            float mu[4], rstd[4];
#pragma unroll
            for (int r = 0; r < 4; ++r) { const int t = 16 * wq + 4 * g + r; float s = 0.f;
#pragma unroll
                for (int et = 0; et < 8; ++et) { const float og = bf2f(OO[t * 128 + 16 * et + l15]); const float hm = o[et][r] / (1.f + __expf(-og)); o[et][r] = hm; s += hm; }
                s += __shfl_xor(s, 1); s += __shfl_xor(s, 2); s += __shfl_xor(s, 4); s += __shfl_xor(s, 8);
                mu[r] = s * (1.f / 128.f); float q = 0.f;
#pragma unroll
                for (int et = 0; et < 8; ++et) { const float dlt = o[et][r] - mu[r]; q += dlt * dlt; }
                q += __shfl_xor(q, 1); q += __shfl_xor(q, 2); q += __shfl_xor(q, 4); q += __shfl_xor(q, 8);
                rstd[r] = 1.f / sqrtf(q * (1.f / 128.f) + EPS_); }
#pragma unroll
            for (int et = 0; et < 8; ++et) { const int e = 16 * et + l15; const float nw = F.ml_norm_w[hh * 128 + e];
#pragma unroll
                for (int r = 0; r < 4; ++r) { const int t = 16 * wq + 4 * g + r; const float z = bf2f(ZZ[t * 128 + e]);
                    F.HMIX[(size_t)(tok0 + t) * D_ + 512 + hh * 128 + e] = (bf16)f2bf((o[et][r] - mu[r]) * rstd[r] * nw * (z / (1.f + __expf(-z)))); } }
        }
        __syncthreads();
    }
}


constexpr int NA_KR = 0, NA_VR = 65536, NA_RPB = 131072, NA_MRG = 133120, NA_ML = NA_MRG + 16384, NA_ROWS = NA_ML + 512, NA_END = NA_ROWS + 1024;
__device__ __forceinline__ void na_ring_store(LAS unsigned char* ring, int kr, int tid, v4u v) { const int key = tid >> 3, ch = tid & 7; *(LAS v4u*)(ring + (kr & 7) * 8192 + key * 128 + ((ch ^ (key & 7)) << 4)) = v; }
__device__ __forceinline__ void na_fast(Frame& F) {
    LAS unsigned char* KR = F.lds + NA_KR; LAS unsigned char* VR = F.lds + NA_VR;
    LAS float* RPB = (LAS float*)(F.lds + NA_RPB);
    LAS f32x4* MRG = (LAS f32x4*)(F.lds + NA_MRG);
    LAS float* ML = (LAS float*)(F.lds + NA_ML);
    LAS float* ROWS = (LAS float*)(F.lds + NA_ROWS);
    const int tid = F.tid, lane = F.lane, l15 = lane & 15, g = lane >> 4, b = F.wave & 3, kh = F.wave >> 2;
    for (int su = blockIdx.x; su < 256; su += F.G) {
        const int hh = su & 7, r0 = (su >> 3) * 8;
        const bf16* kbase = F.PROJ + C_NAK + hh * 64 + (tid & 7) * 8;
        const bf16* vbase = F.PROJ + C_NAV + hh * 64 + (tid & 7) * 8;
        {
            const int rs0 = min(max(r0 - 4, 0), NCH - 8);
            v4u kk[8], vv[8];
#pragma unroll
            for (int j = 0; j < 8; ++j) { const size_t tok = (size_t)((rs0 + j) * 64 + (tid >> 3)); kk[j] = *(const v4u*)(kbase + tok * NP); vv[j] = *(const v4u*)(vbase + tok * NP); }
#pragma unroll
            for (int j = 0; j < 8; ++j) { na_ring_store(KR, rs0 + j, tid, kk[j]); na_ring_store(VR, rs0 + j, tid, vv[j]); }
            if (tid < 15 * 31) RPB[tid] = F.rpb[hh * 15 * 31 + tid];
        }
        __syncthreads();
#pragma unroll 1
        for (int r = r0; r < r0 + 8; ++r) {
            const int rs = min(max(r - 4, 0), NCH - 8), rsn = min(max(r - 3, 0), NCH - 8);
            const bool need_next = (r + 1 < r0 + 8) && (rsn > rs);
            v4u kn = (v4u){0u, 0u, 0u, 0u}, vn = kn;
            if (need_next) { const size_t tok = (size_t)((rsn + 7) * 64 + (tid >> 3)); kn = *(const v4u*)(kbase + tok * NP); vn = *(const v4u*)(vbase + tok * NP); }
            const int c = 16 * b + l15, cw0 = min(max(16 * b - 8, 0), 32), cs = min(max(c - 8, 0), 48);
            const bf16* qrow = F.PROJ + (size_t)(r * 64 + c) * NP + C_NAQ + hh * 64;
            const bf16x8 qf0 = *(const bf16x8*)(qrow + 8 * g), qf1 = *(const bf16x8*)(qrow + 32 + 8 * g);
            f32x4 sacc[8];
#pragma unroll
            for (int tl = 0; tl < 8; ++tl) {
                const int kr = rs + 4 * kh + (tl >> 1), key = cw0 + 16 * (tl & 1) + l15;
                const LAS unsigned char* kp = KR + (kr & 7) * 8192 + key * 128;
                const bf16x8 a0 = *(const LAS bf16x8*)(kp + ((g ^ (key & 7)) << 4)), a1 = *(const LAS bf16x8*)(kp + (((4 + g) ^ (key & 7)) << 4));
                sacc[tl] = MFMA16(a0, qf0, ((f32x4){0.f, 0.f, 0.f, 0.f})); sacc[tl] = MFMA16(a1, qf1, sacc[tl]);
            }
            float m = -1e30f;
#pragma unroll
            for (int tl = 0; tl < 8; ++tl) {
                const int dy = rs + 4 * kh + (tl >> 1) - r + 7;
#pragma unroll
                for (int rr = 0; rr < 4; ++rr) {
                    const int col = cw0 + 16 * (tl & 1) + 4 * g + rr; const bool ok = (col >= cs) && (col < cs + 16);
                    const int dx = min(max(col - c + 15, 0), 30);
                    const float s = ok ? sacc[tl][rr] * 0.125f + RPB[dy * 31 + dx] : -1e30f;
                    sacc[tl][rr] = s; m = fmaxf(m, s);
                }
            }
            m = fmaxf(m, __shfl_xor(m, 16)); m = fmaxf(m, __shfl_xor(m, 32));
            float l = 0.f;
#pragma unroll
            for (int tl = 0; tl < 8; ++tl)
#pragma unroll
                for (int rr = 0; rr < 4; ++rr) { const float p = __expf(sacc[tl][rr] - m); sacc[tl][rr] = p; l += p; }
            l += __shfl_xor(l, 16); l += __shfl_xor(l, 32);
            f32x4 o[4];
#pragma unroll
            for (int dt = 0; dt < 4; ++dt) o[dt] = (f32x4){0.f, 0.f, 0.f, 0.f};
#pragma unroll
            for (int kk = 0; kk < 4; ++kk) {
                const f32x4 x0 = sacc[2 * kk], x1 = sacc[2 * kk + 1];
                const v4u pw = (v4u){pk2(x0.x, x0.y), pk2(x0.z, x0.w), pk2(x1.x, x1.y), pk2(x1.z, x1.w)};
                const bf16x8 pa = __builtin_bit_cast(bf16x8, pw);
                const int kr = rs + 4 * kh + kk, key = cw0 + 4 * g + (l15 >> 2);
                const LAS unsigned char* vp = VR + (kr & 7) * 8192 + key * 128;
#pragma unroll
                for (int dt = 0; dt < 4; ++dt) {
                    const int chv = 2 * dt + ((l15 & 3) >> 1), off = (((chv ^ (key & 7)) << 4) + ((l15 & 1) << 3));
                    const s16x4_t lo = lds_tr4(vp + off), hi = lds_tr4(vp + 16 * 128 + off);
                    const bf16x8 bfr = (bf16x8){lo[0], lo[1], lo[2], lo[3], hi[0], hi[1], hi[2], hi[3]};
                    o[dt] = MFMA16(pa, bfr, o[dt]);
                }
            }
            if (kh == 1) {
#pragma unroll
                for (int dt = 0; dt < 4; ++dt) MRG[(b * 4 + dt) * 64 + lane] = o[dt];
                if (g == 0) { ML[b * 32 + l15] = m; ML[b * 32 + 16 + l15] = l; }
            }
            __syncthreads();
            if (kh == 0) {
                const float m1 = ML[b * 32 + l15], l1 = ML[b * 32 + 16 + l15];
                const float mm = fmaxf(m, m1), a0 = __expf(m - mm), a1 = __expf(m1 - mm), inv = 1.f / (l * a0 + l1 * a1);
                LAS float* rw = ROWS + F.wave * 32;
                if (g == 0) { rw[l15] = a0 * inv; rw[16 + l15] = a1 * inv; }
                const f32x4 f0 = *(const LAS f32x4*)(rw + 4 * g), f1 = *(const LAS f32x4*)(rw + 16 + 4 * g);
#pragma unroll
                for (int dt = 0; dt < 4; ++dt) {
                    const f32x4 o1 = MRG[(b * 4 + dt) * 64 + lane]; const f32x4 ov = o[dt] * f0 + o1 * f1;
#pragma unroll
                    for (int rr = 0; rr < 4; ++rr) {
                        const size_t tok = (size_t)(r * 64 + 16 * b + 4 * g + rr); const int d = hh * 64 + 16 * dt + l15;
                        const float z = bf2f(F.PROJ[tok * NP + C_NAZ + d]);
                        F.HMIX[tok * D_ + d] = (bf16)f2bf(ov[rr] * (z / (1.f + __expf(-z))));
                    }
                }
            }
            __syncthreads();
            if (need_next) { na_ring_store(KR, rsn + 7, tid, kn); na_ring_store(VR, rsn + 7, tid, vn); }
            __syncthreads();
        }
    }
}

struct EpiResGate {
    static constexpr bool PERM = false, AFTER_DRAIN = false;
    const float* x; const float* gate; float* y;
    __device__ __forceinline__ void operator()(const pg8::f32x4 (&acc)[2][2][4][2], const pg8::Unit& u, int wr, int wc, int fr, int fq) const {
        const int col0 = u.pn * 256 + wc * 32 + 4 * fq;
#pragma unroll
        for (int bj = 0; bj < 2; ++bj)
#pragma unroll
            for (int n = 0; n < 2; ++n) { const f32x4 g4 = *(const f32x4*)(gate + col0 + bj * 128 + n * 16);
#pragma unroll
                for (int ai = 0; ai < 2; ++ai)
#pragma unroll
                    for (int m = 0; m < 4; ++m) { const size_t off = (size_t)(u.pm * 256 + ai * 128 + wr * 64 + m * 16 + fr) * D_ + col0 + bj * 128 + n * 16;
                        const f32x4 xv = *(const f32x4*)(x + off); *(f32x4*)(y + off) = xv + g4 * acc[ai][bj][m][n]; } }
    }
};

__device__ __forceinline__ void p7_final(Frame& F) {
    const int gw = blockIdx.x * NWAVES + F.wave, NGW = F.G * NWAVES;
    f32x4 fw[4];
#pragma unroll
    for (int j = 0; j < 4; ++j) fw[j] = *(const f32x4*)(F.final_norm_w + 4 * F.lane + 256 * j);
    for (int m = gw; m < T_; m += NGW) {
        const GAS f32x4* yr = (const GAS f32x4*)(F.ybuf + (size_t)m * D_) + F.lane;
        f32x4 v[4]; float s = 0.f;
#pragma unroll
        for (int j = 0; j < 4; ++j) { v[j] = yr[64 * j]; s += (v[j].x * v[j].x + v[j].y * v[j].y) + (v[j].z * v[j].z + v[j].w * v[j].w); }
        const float rstd = 1.f / sqrtf(wave_sum(s) * (1.f / D_) + EPS_);
        GAS f32x4* o = (GAS f32x4*)(F.out + (size_t)m * D_) + F.lane;
#pragma unroll
        for (int j = 0; j < 4; ++j) o[64 * j] = v[j] * rstd * fw[j];
    }
}

struct Args { const float* in[13]; float* out; unsigned char* ws; int ph_lo, ph_hi; };
__global__ void __launch_bounds__(NWAVES * 64, 2) mk_fwd(Args args) {
    extern __shared__ __attribute__((aligned(16))) unsigned char lds[];
    Frame F;
    F.lds = (LAS unsigned char*)lds;
    F.MISC = (volatile LAS unsigned*)(F.lds + MISC_OFF);
    F.tid = threadIdx.x; F.lane = F.tid & 63; F.wave = __builtin_amdgcn_readfirstlane(F.tid >> 6); F.G = gridDim.x;
    unsigned char* ws = args.ws;
    F.x = args.in[0]; F.c = args.in[1]; F.w_ada = args.in[2]; F.b_ada = args.in[3]; F.norm_w = args.in[4]; F.w_in = args.in[5]; F.b_in = args.in[6];
    F.conv_w = args.in[7]; F.conv_b = args.in[8]; F.rpb = args.in[9]; F.ml_norm_w = args.in[10]; F.w_out = args.in[11]; F.final_norm_w = args.in[12];
    F.out = args.out;
    F.mod = (float*)(ws + WS_MOD); F.biasp = (float*)(ws + WS_BIASP); F.BL = (float*)(ws + WS_BL); F.MLOC = (float*)(ws + WS_MLOC); F.MPREV = (float*)(ws + WS_MPREV);
    F.NVEC = (float*)(ws + WS_NVEC); F.ybuf = (float*)(ws + WS_YBUF);
    F.WT1 = (bf16*)(ws + WS_WT1); F.WT2 = (bf16*)(ws + WS_WT2); F.HMIX = (bf16*)(ws + WS_HMIX); F.PROJ = (bf16*)(ws + WS_PROJ); F.UC = (bf16*)args.out;
    for (int u = F.tid; u < 64; u += NWAVES * 64) ((LAS unsigned*)(F.lds + MISC_OFF))[u] = 0u;
    __syncthreads();
    const int lo = args.ph_lo, hi = args.ph_hi;
    const bool one = (hi - lo) > 1;
    XcdBarrier bar; bar.bar = (unsigned*)(ws + WS_CTL) + CW_BAR; bar.x = 0; bar.st = nullptr;
    if (one) bar = xcd_barrier_post((unsigned*)(ws + WS_CTL) + CW_BAR, F.MISC + 8);
#define IN(k) (lo <= (k) && (k) < hi)
#define SEAM(k) do { if (IN(k) && IN((k) + 1)) xcd_barrier(bar); } while (0)
    if (IN(0)) { p0_mod(F); } SEAM(0);
    if (IN(1)) { p1_prep(F); } SEAM(1);
    if (IN(2)) {
        pg8::Gemm g{F.HMIX, F.WT1, T_, NP, D_}; pg8::StaticOrder S; S.init(T_, NP, F.G, (int)blockIdx.x);
        pg8::EpiBf16<0> E{F.PROJ, NP, F.biasp, 0, 0, 1.f};
        pg8::gemm_phase<pg8::EpiBf16<0>, pg8::StaticOrder, PG8_ALIGN, PG8_SP2>(F.lds, g, S, E);
    } SEAM(2);
    if (IN(3)) { NA_FN(F); MLA_FN(F); } SEAM(3);
    if (IN(4)) { ml_scan(F); } SEAM(4);
    if (IN(5)) { MLO_FN(F); } SEAM(5);
    if (IN(6)) {
        pg8::Gemm g{F.HMIX, F.WT2, T_, D_, D_}; pg8::StaticOrder S; S.init(T_, D_, F.G, (int)blockIdx.x);
        EpiResGate E{F.x, F.mod + 2048, F.ybuf};
        pg8::gemm_phase<EpiResGate, pg8::StaticOrder, false, PG8_SP2>(F.lds, g, S, E);
    } SEAM(6);
    if (IN(7)) { p7_final(F); }
#undef IN
#undef SEAM
}

extern "C" void kernel_launch(void* const* d_in, const int* in_sizes, int n_in, void* d_out, int out_size, void* d_ws, size_t ws_size, hipStream_t stream) {
    static int grid = 0;
    if (grid == 0) {
        if (n_in != 13 || in_sizes[0] != T_ * D_ || out_size != T_ * D_ || ws_size < WS_END) { fprintf(stderr, "kernel_launch: unexpected shapes (n_in %d, in0 %d, out %d, ws %zu); nothing launched\n", n_in, n_in > 0 ? in_sizes[0] : -1, out_size, ws_size); grid = -1; return; }
        int dev = 0, cus = 0, per_cu = 0;
        if (hipGetDevice(&dev) != hipSuccess || hipDeviceGetAttribute(&cus, hipDeviceAttributeMultiprocessorCount, dev) != hipSuccess) { grid = -1; return; }
        if (hipFuncSetAttribute((const void*)mk_fwd, hipFuncAttributeMaxDynamicSharedMemorySize, LDS_BYTES) != hipSuccess) { fprintf(stderr, "kernel_launch: hipFuncSetAttribute failed\n"); grid = -1; return; }
        if (hipOccupancyMaxActiveBlocksPerMultiprocessor(&per_cu, (const void*)mk_fwd, NWAVES * 64, LDS_BYTES) != hipSuccess || per_cu < 1) { fprintf(stderr, "kernel_launch: occupancy query says %d blocks per CU; nothing launched\n", per_cu); grid = -1; return; }
        (void)hipGetLastError();
        grid = cus;
    }
    if (grid < 0) return;
    (void)hipMemsetAsync((char*)d_ws + WS_CTL, 0, CTL_ZERO_BYTES, stream);
    Args a{};
    for (int i = 0; i < 13; ++i) a.in[i] = (const float*)d_in[i];
    a.out = (float*)d_out; a.ws = (unsigned char*)d_ws;
#if MK_N_LAUNCHES == 1
    a.ph_lo = 0; a.ph_hi = N_PHASES;
    hipLaunchKernelGGL(mk_fwd, dim3(grid), dim3(NWAVES * 64), LDS_BYTES, stream, a);
#else
    for (int p = 0; p < N_PHASES; ++p) { a.ph_lo = p; a.ph_hi = p + 1; hipLaunchKernelGGL(mk_fwd, dim3(grid), dim3(NWAVES * 64), LDS_BYTES, stream, a); }
#endif
}
```
